# Optimizing an MI355X kernel written in HIP

```python
import jax, jax.numpy as jnp
from jax import lax
import numpy as np

D_MODEL = 1024
BATCH = 8
SEQ = 8192
DEPTH = 2

GRID_W = 64
QBLK = 128
ROPE_THETA = 10000.0
HEAD_DIM = 64
A_HEADS = 8
A_KV = 2
B_HEADS = 8
B_KV = 2
WINDOW = 128
AB_IN = (A_HEADS + 2 * A_KV + B_HEADS + 2 * B_KV) * HEAD_DIM
AB_MIX = (A_HEADS + B_HEADS) * HEAD_DIM
MLA_HEADS = 16
Q_LORA = 256
KV_LORA = 128
QK_NOPE = 64
QK_ROPE = 32
V_DIM = 64
MLA_DOWN = Q_LORA + KV_LORA + QK_ROPE
N_EXPERTS = 16
EC_FACTOR = 2
D_EXPERT = 1024
N_EVEN = (DEPTH + 1) // 2
N_ODD = DEPTH // 2
ALPHA = (2.0 * DEPTH) ** 0.25
BETA = (8.0 * DEPTH) ** -0.25
NEG_INF = -1e30

kernel_name = "hybrid_axialgqa_swa_mla_ecmoe_deepnorm"


def rms_norm(x, g, eps=1e-6):
    xf = x.astype(jnp.float32)
    y = xf * lax.rsqrt(jnp.mean(xf * xf, axis=-1, keepdims=True) + eps)
    return (y * g.astype(jnp.float32)).astype(x.dtype)


def layer_norm(x, g, b, eps=1e-5):
    xf = x.astype(jnp.float32)
    mu = jnp.mean(xf, axis=-1, keepdims=True)
    var = jnp.mean(jnp.square(xf - mu), axis=-1, keepdims=True)
    y = (xf - mu) * lax.rsqrt(var + eps)
    return (y * g.astype(jnp.float32) + b.astype(jnp.float32)).astype(x.dtype)


def rope_angles(pos, dim):
    freqs = ROPE_THETA ** (-(jnp.arange(0, dim, 2, dtype=jnp.float32) / dim))
    return pos[:, None] * freqs[None, :]


def apply_rope(x, ang):
    cos = jnp.cos(ang)[None, :, None, :]
    sin = jnp.sin(ang)[None, :, None, :]
    xf = x.astype(jnp.float32)
    x1, x2 = jnp.split(xf, 2, axis=-1)
    return jnp.concatenate([x1 * cos - x2 * sin, x2 * cos + x1 * sin], axis=-1).astype(x.dtype)


def apply_axial_rope(x, ang_row, ang_col):
    half = x.shape[-1] // 2
    return jnp.concatenate([apply_rope(x[..., :half], ang_row),
                            apply_rope(x[..., half:], ang_col)], axis=-1)


def dense_attention(q, k, v, scale):
    B, S, H, dq = q.shape
    KV = k.shape[2]
    G = H // KV
    dv = v.shape[-1]
    nb = S // QBLK
    qb = q.reshape(B, nb, QBLK, KV, G, dq).transpose(1, 0, 2, 3, 4, 5)

    def one_block(qblk):
        s = jnp.einsum('bqkgd,bskd->bkgqs', qblk, k, preferred_element_type=jnp.float32) * scale
        p = jax.nn.softmax(s, axis=-1).astype(v.dtype)
        return jnp.einsum('bkgqs,bskd->bqkgd', p, v)

    o = lax.map(one_block, qb)
    return o.transpose(1, 0, 2, 3, 4, 5).reshape(B, S, H * dv)


def window_attention(q, k, v, sink, scale):
    B, S, H, d = q.shape
    KV = k.shape[2]
    G = H // KV
    dv = v.shape[-1]
    nb = S // QBLK
    span = QBLK + 2 * WINDOW
    pad = ((0, 0), (WINDOW, WINDOW), (0, 0), (0, 0))
    kp = jnp.pad(k, pad)
    vp = jnp.pad(v, pad)
    qb = q.reshape(B, nb, QBLK, KV, G, d).transpose(1, 0, 2, 3, 4, 5)
    offs = jnp.arange(span) - WINDOW
    qa = jnp.arange(QBLK)
    rel_ok = jnp.abs(offs[None, :] - qa[:, None]) <= WINDOW
    sink_l = sink.astype(jnp.float32).reshape(KV, G)[None, :, :, None, None]

    def one_block(args):
        qblk, i = args
        start = i * QBLK
        kw = lax.dynamic_slice_in_dim(kp, start, span, axis=1)
        vw = lax.dynamic_slice_in_dim(vp, start, span, axis=1)
        kpos = start + offs
        valid = rel_ok & ((kpos >= 0) & (kpos < S))[None, :]
        s = jnp.einsum('bqkgd,bskd->bkgqs', qblk, kw, preferred_element_type=jnp.float32) * scale
        s = jnp.where(valid[None, None, None], s, NEG_INF)
        s = jnp.concatenate([s, jnp.broadcast_to(sink_l, s.shape[:-1] + (1,))], axis=-1)
        p = jax.nn.softmax(s, axis=-1)[..., :-1].astype(vw.dtype)
        return jnp.einsum('bkgqs,bskd->bqkgd', p, vw)

    o = lax.map(one_block, (qb, jnp.arange(nb)))
    return o.transpose(1, 0, 2, 3, 4, 5).reshape(B, S, H * dv)


def mix_ab(x, w_in, q_norm, k_norm, sink, w_out):
    B, S, _ = x.shape
    proj = x @ w_in
    sizes = [A_HEADS * HEAD_DIM, A_KV * HEAD_DIM, A_KV * HEAD_DIM,
             B_HEADS * HEAD_DIM, B_KV * HEAD_DIM, B_KV * HEAD_DIM]
    cuts = list(np.cumsum(sizes)[:-1])
    qa, ka, va, qb, kb, vb = jnp.split(proj, cuts, axis=-1)
    rows = S // GRID_W
    row_pos = jnp.repeat(jnp.arange(rows, dtype=jnp.float32), GRID_W)
    col_pos = jnp.tile(jnp.arange(GRID_W, dtype=jnp.float32), rows)
    seq_pos = jnp.arange(S, dtype=jnp.float32)
    ang_row = rope_angles(row_pos, HEAD_DIM // 2)
    ang_col = rope_angles(col_pos, HEAD_DIM // 2)
    ang_seq = rope_angles(seq_pos, HEAD_DIM)
    qa = apply_axial_rope(rms_norm(qa.reshape(B, S, A_HEADS, HEAD_DIM), q_norm), ang_row, ang_col)
    ka = apply_axial_rope(rms_norm(ka.reshape(B, S, A_KV, HEAD_DIM), k_norm), ang_row, ang_col)
    va = va.reshape(B, S, A_KV, HEAD_DIM)
    oa = dense_attention(qa, ka, va, HEAD_DIM ** -0.5)
    qb = apply_rope(qb.reshape(B, S, B_HEADS, HEAD_DIM), ang_seq)
    kb = apply_rope(kb.reshape(B, S, B_KV, HEAD_DIM), ang_seq)
    vb = vb.reshape(B, S, B_KV, HEAD_DIM)
    ob = window_attention(qb, kb, vb, sink, HEAD_DIM ** -0.5)
    return jnp.concatenate([oa, ob], axis=-1) @ w_out


def mix_mla(x, w_down, q_norm, kv_norm, w_uq, w_ukv, w_out):
    B, S, _ = x.shape
    proj = x @ w_down
    c_q, c_kv, k_r = jnp.split(proj, [Q_LORA, Q_LORA + KV_LORA], axis=-1)
    q = (rms_norm(c_q, q_norm) @ w_uq).reshape(B, S, MLA_HEADS, QK_NOPE + QK_ROPE)
    kv = (rms_norm(c_kv, kv_norm) @ w_ukv).reshape(B, S, MLA_HEADS, QK_NOPE + V_DIM)
    q_nope, q_rope = jnp.split(q, [QK_NOPE], axis=-1)
    k_nope, v = jnp.split(kv, [QK_NOPE], axis=-1)
    ang = rope_angles(jnp.arange(S, dtype=jnp.float32), QK_ROPE)
    q_rope = apply_rope(q_rope, ang)
    k_r = apply_rope(k_r[:, :, None, :], ang)
    q = jnp.concatenate([q_nope, q_rope], axis=-1)
    k = jnp.concatenate([k_nope, jnp.broadcast_to(k_r, (B, S, MLA_HEADS, QK_ROPE))], axis=-1)
    o = dense_attention(q, k, v, (QK_NOPE + QK_ROPE) ** -0.5)
    return o @ w_out


def ec_moe(x, w_router, w_gate, w_up, w_down):
    B, S, D = x.shape
    cap = EC_FACTOR * S // N_EXPERTS
    logits = jnp.einsum('bsd,de->bse', x, w_router, preferred_element_type=jnp.float32)
    aff = jax.nn.softmax(logits, axis=-1)
    g, idx = lax.top_k(aff.transpose(0, 2, 1), cap)
    xg = jax.vmap(lambda xb, ib: xb[ib])(x, idx)
    h = jax.nn.silu(jnp.einsum('becd,edf->becf', xg, w_gate)) * jnp.einsum('becd,edf->becf', xg, w_up)
    y = jnp.einsum('becf,efd->becd', h, w_down) * g[..., None].astype(x.dtype)
    return jax.vmap(lambda yb, ib: jnp.zeros((S, D), x.dtype).at[ib.reshape(-1)].add(yb.reshape(-1, D)))(y, idx)


def setup_inputs(seed: int = 0) -> dict:
    key = jax.random.key(seed)
    ks = iter(jax.random.split(key, 32))

    def nrm(shape, scale):
        return jax.random.normal(next(ks), shape, jnp.float32) * scale

    D = D_MODEL
    return {
        "x": nrm((BATCH, SEQ, D), 1.0),
        "ab_w_in": nrm((N_EVEN, D, AB_IN), D ** -0.5),
        "ab_q_norm": 1.0 + nrm((N_EVEN, HEAD_DIM), 0.02),
        "ab_k_norm": 1.0 + nrm((N_EVEN, HEAD_DIM), 0.02),
        "ab_sink": nrm((N_EVEN, B_HEADS), 1.0),
        "ab_w_out": nrm((N_EVEN, AB_MIX, D), BETA * AB_MIX ** -0.5),
        "mla_w_down": nrm((N_ODD, D, MLA_DOWN), D ** -0.5),
        "mla_q_norm": 1.0 + nrm((N_ODD, Q_LORA), 0.02),
        "mla_kv_norm": 1.0 + nrm((N_ODD, KV_LORA), 0.02),
        "mla_w_uq": nrm((N_ODD, Q_LORA, MLA_HEADS * (QK_NOPE + QK_ROPE)), Q_LORA ** -0.5),
        "mla_w_ukv": nrm((N_ODD, KV_LORA, MLA_HEADS * (QK_NOPE + V_DIM)), KV_LORA ** -0.5),
        "mla_w_out": nrm((N_ODD, MLA_HEADS * V_DIM, D), BETA * (MLA_HEADS * V_DIM) ** -0.5),
        "ln_mix_g": 1.0 + nrm((DEPTH, D), 0.02),
        "ln_mix_b": nrm((DEPTH, D), 0.02),
        "moe_router": nrm((DEPTH, D, N_EXPERTS), D ** -0.5),
        "moe_w_gate": nrm((DEPTH, N_EXPERTS, D, D_EXPERT), D ** -0.5),
        "moe_w_up": nrm((DEPTH, N_EXPERTS, D, D_EXPERT), D ** -0.5),
        "moe_w_down": nrm((DEPTH, N_EXPERTS, D_EXPERT, D), BETA * D_EXPERT ** -0.5),
        "ln_ffn_g": 1.0 + nrm((DEPTH, D), 0.02),
        "ln_ffn_b": nrm((DEPTH, D), 0.02),
    }


def reference(x, ab_w_in, ab_q_norm, ab_k_norm, ab_sink, ab_w_out,
              mla_w_down, mla_q_norm, mla_kv_norm, mla_w_uq, mla_w_ukv, mla_w_out,
              ln_mix_g, ln_mix_b, moe_router, moe_w_gate, moe_w_up, moe_w_down,
              ln_ffn_g, ln_ffn_b):
    for l in range(DEPTH):
        i = l // 2
        if l % 2 == 0:
            h = mix_ab(x, ab_w_in[i], ab_q_norm[i], ab_k_norm[i], ab_sink[i], ab_w_out[i])
        else:
            h = mix_mla(x, mla_w_down[i], mla_q_norm[i], mla_kv_norm[i],
                        mla_w_uq[i], mla_w_ukv[i], mla_w_out[i])
        x = layer_norm(ALPHA * x + h, ln_mix_g[l], ln_mix_b[l])
        f = ec_moe(x, moe_router[l], moe_w_gate[l], moe_w_up[l], moe_w_down[l])
        x = layer_norm(ALPHA * x + f, ln_ffn_g[l], ln_ffn_b[l])
    return x
```

```cpp
#include <hip/hip_runtime.h>
#include <hip/hip_cooperative_groups.h>
#include <cstdio>
#include <cstdint>
namespace cg = cooperative_groups;

#define LAS __attribute__((address_space(3)))
typedef unsigned short bf16_t;
typedef short bf16x8 __attribute__((ext_vector_type(8)));
typedef short s16x4 __attribute__((ext_vector_type(4)));
typedef float f32x4 __attribute__((ext_vector_type(4)));
typedef float f32x2 __attribute__((ext_vector_type(2)));
typedef float f32x16 __attribute__((ext_vector_type(16)));
typedef unsigned u32x4 __attribute__((ext_vector_type(4)));
typedef unsigned u32x2 __attribute__((ext_vector_type(2)));

constexpr int T_TOK = 65536, DM = 1024, SEQ = 8192;
constexpr float ALPHA = 1.4142135623730951f;
constexpr int LDS_BYTES = 131072 + 64;

constexpr size_t MiB = 1048576;
constexpr size_t W_IN0 = 0, W_OUT0 = 3 * MiB, W_GU0 = 5 * MiB, W_D0 = 69 * MiB, W_DN1 = 101 * MiB, W_UQ = 102 * MiB, W_UKV = 103 * MiB,
                 W_OUT1 = 104 * MiB, W_GU1 = 106 * MiB, W_D1 = 170 * MiB;
constexpr size_t WS_TAB = 202 * MiB;
constexpr size_t TAB_SEQ_C = WS_TAB, TAB_SEQ_S = WS_TAB + 1 * MiB, TAB_MLA_C = WS_TAB + 2 * MiB, TAB_MLA_S = WS_TAB + 2 * MiB + 512 * 1024,
                 TAB_ROW_C = WS_TAB + 3 * MiB, TAB_ROW_S = TAB_ROW_C + 8192, TAB_COL_C = TAB_ROW_S + 8192, TAB_COL_S = TAB_COL_C + 4096;
constexpr size_t WS_BAR = WS_TAB + 3 * MiB + 65536;
constexpr size_t WS_STATS = WS_TAB + 3 * MiB + 131072;
constexpr size_t WS_AFF = 206 * MiB, WS_IDX = 210 * MiB, WS_GATE = 210 * MiB + 512 * 1024, WS_SLOT = 211 * MiB;
constexpr size_t WS_XB = 216 * MiB;
constexpr size_t WS_CQN = WS_XB, WS_CKVN = WS_XB + 32 * MiB, WS_KR = WS_XB + 48 * MiB;
constexpr size_t WS_R = 344 * MiB;
constexpr size_t WS_PROJ = WS_R, WS_ATT0 = WS_R + 192 * MiB;
constexpr size_t WS_Q = WS_R, WS_KV = WS_R + 192 * MiB, WS_ATT1 = WS_R + 448 * MiB, WS_RAWDN = WS_R + 448 * MiB;
constexpr size_t WS_XG = WS_R, WS_H = WS_R + 256 * MiB, WS_Y = WS_R;
constexpr size_t WS_END = WS_R + 576 * MiB;

struct Params {
    const float* in[20];
    float* out;
    unsigned char* ws;
    int ph_lo, ph_hi;
};

__device__ __forceinline__ unsigned cvtpk(float lo, float hi) { unsigned r; asm volatile("v_cvt_pk_bf16_f32 %0, %1, %2" : "=v"(r) : "v"(lo), "v"(hi)); return r; }
__device__ __forceinline__ int otid() { int t = threadIdx.x; asm volatile("" : "+v"(t)); return t; }
__device__ __forceinline__ float bf2f(unsigned short b) { return __uint_as_float(((unsigned)b) << 16); }
__device__ __forceinline__ float dpp_f(float v, const int ctrl_sel) {
    const int iv = __builtin_bit_cast(int, v); int r;
    switch (ctrl_sel) { case 1: r = __builtin_amdgcn_update_dpp(0, iv, 0x111, 0xf, 0xf, true); break; case 2: r = __builtin_amdgcn_update_dpp(0, iv, 0x112, 0xf, 0xf, true); break;
                        case 4: r = __builtin_amdgcn_update_dpp(0, iv, 0x114, 0xf, 0xf, true); break; case 8: r = __builtin_amdgcn_update_dpp(0, iv, 0x118, 0xf, 0xf, true); break;
                        case 15: r = __builtin_amdgcn_update_dpp(0, iv, 0x142, 0xa, 0xf, false); break; default: r = __builtin_amdgcn_update_dpp(0, iv, 0x143, 0xc, 0xf, false); break; }
    return __builtin_bit_cast(float, r);
}
__device__ __forceinline__ float wave_sum(float v) {
    v += dpp_f(v, 1); v += dpp_f(v, 2); v += dpp_f(v, 4); v += dpp_f(v, 8); v += dpp_f(v, 15); v += dpp_f(v, 31);
    return __builtin_bit_cast(float, __builtin_amdgcn_readlane(__builtin_bit_cast(int, v), 63));
}

enum { MAP_NAT = 0, MAP_P32 = 1, MAP_GU = 2, MAP_QKV0 = 3, MAP_UQ = 4, MAP_DN1 = 5 };
__device__ __forceinline__ int map_src(int mode, int ns, int& which) {
    which = 0;
    const int t = ns >> 8, s = ns & 255, bj = s >> 7, wc = (s >> 5) & 3, rho = s & 31;
    const int q32 = ((rho >> 2) & 3) * 8 + (rho >> 4) * 4 + (rho & 3);
    if (mode == MAP_NAT) return ns;
    if (mode == MAP_DN1) return ns < 416 ? ns : -1;
    if (mode == MAP_P32) return (ns & ~31) + q32;
    if (mode == MAP_GU) { which = bj; return t * 128 + wc * 32 + q32; }
    if (mode == MAP_QKV0) {
        const int head = 4 * t + wc, pp = 32 * bj + q32;
        int orig;
        if (head < 10) { const int blk = pp >> 5, q = pp & 31; orig = blk * 32 + (q & 1) * 16 + (q >> 1); }
        else if (head >= 12 && head < 22) { orig = (pp & 1) * 32 + (pp >> 1); }
        else orig = pp;
        return head * 64 + orig;
    }
    const int c = (ns & ~31) + q32; const int g = c >> 5, head = g / 3, part = g - head * 3;
    const int orig = part < 2 ? part * 32 + q32 : 64 + (q32 & 1) * 16 + (q32 >> 1);
    return head * 96 + orig;
}

__device__ __forceinline__ void cvt_tile(const float* s0, const float* s1, int ld, int mode, bf16_t* dst, int K, int n0, int k0, float* tl) {
    const int tid = otid();
    const int nl = tid & 63, kb = tid >> 6;
    int which; const int sc = map_src(mode, n0 + nl, which);
    const float* src = which ? s1 : s0;
    float ld_[16];
#pragma unroll
    for (int i = 0; i < 16; ++i) { const int k = i * 8 + kb; ld_[i] = sc >= 0 ? src[(size_t)(k0 + k) * ld + sc] : 0.f; }
#pragma unroll
    for (int i = 0; i < 16; ++i) { const int k = i * 8 + kb; tl[k * 65 + nl] = ld_[i]; }
    __syncthreads();
    const int nr = tid >> 3, kc = (tid & 7) * 8;
#pragma unroll
    for (int h = 0; h < 2; ++h) {
        float v[8];
#pragma unroll
        for (int j = 0; j < 8; ++j) v[j] = tl[(h * 64 + kc + j) * 65 + nr];
        u32x4 w = {cvtpk(v[0], v[1]), cvtpk(v[2], v[3]), cvtpk(v[4], v[5]), cvtpk(v[6], v[7])};
        *(u32x4*)(dst + (size_t)(n0 + nr) * K + k0 + h * 64 + kc) = w;
    }
    __syncthreads();
}

__device__ __forceinline__ void cvt_tile_w(const float* s0, const float* s1, int ld, int mode, bf16_t* dst, int K, int n0, int k0, float* tl) {
    const int tid = otid();
    const int n4 = tid & 15, kb = tid >> 4;
    int which; const int sc = map_src(mode, n0 + 4 * n4, which);
    const float* src = (which ? s1 : s0) + sc;
    f32x4 ld_[8];
#pragma unroll
    for (int i = 0; i < 8; ++i) ld_[i] = *(const f32x4*)(src + (size_t)(k0 + i * 32 + kb) * ld);
#pragma unroll
    for (int i = 0; i < 8; ++i) { float* t = tl + (i * 32 + kb) * 65 + 4 * n4; t[0] = ld_[i][0]; t[1] = ld_[i][1]; t[2] = ld_[i][2]; t[3] = ld_[i][3]; }
    __syncthreads();
    const int nr = tid >> 3, kc = (tid & 7) * 8;
#pragma unroll
    for (int h = 0; h < 4; ++h) {
        float v[8];
#pragma unroll
        for (int j = 0; j < 8; ++j) v[j] = tl[(h * 64 + kc + j) * 65 + nr];
        u32x4 w = {cvtpk(v[0], v[1]), cvtpk(v[2], v[3]), cvtpk(v[4], v[5]), cvtpk(v[6], v[7])};
        *(u32x4*)(dst + (size_t)(n0 + nr) * K + k0 + h * 64 + kc) = w;
    }
    __syncthreads();
}

__device__ __forceinline__ void cvt_job(const float* s0, const float* s1, size_t estride, int nexp, int ld, int mode, int K, int N, bf16_t* dst, int& tbase, float* tl) {
    if ((mode == MAP_NAT || mode == MAP_P32 || mode == MAP_GU) && (K & 255) == 0) {
        const int kt_n = K >> 8, tpe = (N >> 6) * kt_n, nt = nexp * tpe, G = gridDim.x;
        const int first = ((int)blockIdx.x - (tbase % G) + G) % G;
        for (int t = first; t < nt; t += G) {
            const int e = t / tpe, r = t - e * tpe, ntile = r / kt_n, kt = r - ntile * kt_n;
            cvt_tile_w(s0 + (size_t)e * estride, s1 + (size_t)e * estride, ld, mode, dst + (size_t)e * N * K, K, ntile * 64, kt * 256, tl);
        }
        tbase += nt;
        return;
    }
    const int kt_n = K >> 7, tpe = (N >> 6) * kt_n, nt = nexp * tpe, G = gridDim.x;
    const int first = ((int)blockIdx.x - (tbase % G) + G) % G;
    for (int t = first; t < nt; t += G) {
        const int e = t / tpe, r = t - e * tpe, ntile = r / kt_n, kt = r - ntile * kt_n;
        cvt_tile(s0 + (size_t)e * estride, s1 + (size_t)e * estride, ld, mode, dst + (size_t)e * N * K, K, ntile * 64, kt * 128, tl);
    }
    tbase += nt;
}

__device__ __forceinline__ void sincos_acc(float ang, float& c, float& s) {
    const double a = (double)ang; const double n = rint(a * 0.15915494309189535);
    double r = fma(-n, 6.283185307179586, a); r = fma(-n, 2.4492935982947064e-16, r);
    const float rf = (float)r; c = cosf(rf); s = sinf(rf);
}
__device__ __forceinline__ float rope_freq(int i, int dim) { return (float)exp2(-((double)(2 * i) / (double)dim) * 13.287712379549449); }

__device__ __forceinline__ void phase_convert(const Params& p, unsigned char* lds) {
    float* tl = (float*)lds;
    unsigned char* ws = p.ws;
    int tb = 0;
    const size_t EW = (size_t)1024 * 1024;
#pragma unroll 1
    for (int j = 0; j < 10; ++j) {
        const float *s0, *s1; size_t es = 0, dsto; int nexp = 1, ld, mode, K, N;
        switch (j) {
            case 0: s0 = s1 = p.in[1]; ld = 1536; mode = MAP_QKV0; K = 1024; N = 1536; dsto = W_IN0; break;
            case 1: s0 = s1 = p.in[5]; ld = 1024; mode = MAP_NAT; K = 1024; N = 1024; dsto = W_OUT0; break;
            case 2: s0 = p.in[15]; s1 = p.in[16]; es = EW; nexp = 16; ld = 1024; mode = MAP_GU; K = 1024; N = 2048; dsto = W_GU0; break;
            case 3: s0 = s1 = p.in[17]; es = EW; nexp = 16; ld = 1024; mode = MAP_P32; K = 1024; N = 1024; dsto = W_D0; break;
            case 4: s0 = s1 = p.in[6]; ld = 416; mode = MAP_DN1; K = 1024; N = 512; dsto = W_DN1; break;
            case 5: s0 = s1 = p.in[9]; ld = 1536; mode = MAP_UQ; K = 256; N = 1536; dsto = W_UQ; break;
            case 6: s0 = s1 = p.in[10]; ld = 2048; mode = MAP_P32; K = 128; N = 2048; dsto = W_UKV; break;
            case 7: s0 = s1 = p.in[11]; ld = 1024; mode = MAP_NAT; K = 1024; N = 1024; dsto = W_OUT1; break;
            case 8: s0 = p.in[15] + 16 * EW; s1 = p.in[16] + 16 * EW; es = EW; nexp = 16; ld = 1024; mode = MAP_GU; K = 1024; N = 2048; dsto = W_GU1; break;
            default: s0 = s1 = p.in[17] + 16 * EW; es = EW; nexp = 16; ld = 1024; mode = MAP_P32; K = 1024; N = 1024; dsto = W_D1; break;
        }
        cvt_job(s0, s1, es, nexp, ld, mode, K, N, (bf16_t*)(ws + dsto), tb, tl);
    }
    {
        const float* x = p.in[0]; bf16_t* xb = (bf16_t*)(ws + WS_XB);
        const size_t n8 = (size_t)T_TOK * DM / 8;
        const size_t st8 = (size_t)gridDim.x * 512;
        size_t i = (size_t)blockIdx.x * 512 + otid();
        for (; i + 3 * st8 < n8; i += 4 * st8) {
            f32x4 a[4], b[4];
#pragma unroll
            for (int u = 0; u < 4; ++u) { a[u] = *(const f32x4*)(x + (i + u * st8) * 8); b[u] = *(const f32x4*)(x + (i + u * st8) * 8 + 4); }
#pragma unroll
            for (int u = 0; u < 4; ++u) { u32x4 w = {cvtpk(a[u][0], a[u][1]), cvtpk(a[u][2], a[u][3]), cvtpk(b[u][0], b[u][1]), cvtpk(b[u][2], b[u][3])};
                *(u32x4*)(xb + (i + u * st8) * 8) = w; }
        }
        for (; i < n8; i += st8) {
            const f32x4 a = *(const f32x4*)(x + i * 8), b = *(const f32x4*)(x + i * 8 + 4);
            u32x4 w = {cvtpk(a[0], a[1]), cvtpk(a[2], a[3]), cvtpk(b[0], b[1]), cvtpk(b[2], b[3])};
            *(u32x4*)(xb + i * 8) = w;
        }
    }
    {
        float* sc_ = (float*)(ws + TAB_SEQ_C); float* ss_ = (float*)(ws + TAB_SEQ_S);
        float* mc_ = (float*)(ws + TAB_MLA_C); float* ms_ = (float*)(ws + TAB_MLA_S);
        float* rc_ = (float*)(ws + TAB_ROW_C); float* rs_ = (float*)(ws + TAB_ROW_S);
        float* cc_ = (float*)(ws + TAB_COL_C); float* cs_ = (float*)(ws + TAB_COL_S);
        const int n1 = SEQ * 32, n2 = SEQ * 16, n3 = 128 * 16, n4 = 64 * 16, ntot = n1 + n2 + n3 + n4;
        for (int i = blockIdx.x * 512 + otid(); i < ntot; i += gridDim.x * 512) {
            float c, s;
            if (i < n1) { const int pos = i >> 5, f = i & 31; sincos_acc((float)pos * rope_freq(f, 64), c, s); sc_[i] = c; ss_[i] = s; }
            else if (i < n1 + n2) { const int j = i - n1, pos = j >> 4, f = j & 15; sincos_acc((float)pos * rope_freq(f, 32), c, s); mc_[j] = c; ms_[j] = s; }
            else if (i < n1 + n2 + n3) { const int j = i - n1 - n2, pos = j >> 4, f = j & 15; sincos_acc((float)pos * rope_freq(f, 32), c, s); rc_[j] = c; rs_[j] = s; }
            else { const int j = i - n1 - n2 - n3, pos = j >> 4, f = j & 15; sincos_acc((float)pos * rope_freq(f, 32), c, s); cc_[j] = c; cs_[j] = s; }
        }
    }
}

constexpr int BM = 256, BK = 64, HALF = 128, HTB = HALF * BK * 2, STAGE_BYTES = 8 * HTB;
__device__ __forceinline__ int lds_byte(int r, int c) { const int st = (r >> 4) * 2 + (c >> 5), rr = r & 15, cc = c & 31, ob = rr * 64 + cc * 2; return st * 1024 + (ob ^ (((ob >> 9) & 1) << 5)); }
__device__ __forceinline__ void stage_rc(int b, int& R, int& C) { const int st = b / 1024, sb = b % 1024, swz = sb ^ (((sb >> 9) & 1) << 5); R = (st >> 1) * 16 + swz / 64; C = (st & 1) * 32 + (swz % 64) / 2; }

struct Unit { int arow, brow, orow, pn; };
struct Sched {
    int nM, nN, total, G, c, moe;
    __device__ __forceinline__ bool next(int i, Unit& u) const {
        const int L = i * G + c; if (L >= total) return false;
        if (!moe) {
            int wgid = L; { const int q = total / 8, r = total % 8, xcd = wgid % 8, off = wgid / 8; wgid = (xcd < r ? xcd * (q + 1) : r * (q + 1) + (xcd - r) * q) + off; }
            const int nig = 8 * nN, gid = wgid / nig, fm = gid * 8, gsz = (nM - fm) < 8 ? (nM - fm) : 8;
            const int pm = fm + ((wgid % nig) % gsz), pn = (wgid % nig) / gsz;
            u.arow = pm * 256; u.brow = pn * 256; u.orow = u.arow; u.pn = pn; return true;
        }
        const int upg = nM * nN; const int g = L / upg, r = L - g * upg; const int pn = r / nM, pm = r - pn * nM;
        const int e = g >> 3, b = g & 7; const int ga = b * 16 + e, gb = e;
        u.arow = (ga * nM + pm) * 256; u.brow = (gb * nN + pn) * 256; u.orow = u.arow; u.pn = pn; return true;
    }
};

template <class Epi, bool GATHER = false>
__device__ __forceinline__ void gemm_phase(LAS unsigned char* lds, const bf16_t* A, const bf16_t* Bt, const int K_, const Sched& S, const Epi& E, const int* gidx = nullptr) {
    int K = K_; asm volatile("" : "+s"(K));
    const int tid = otid(), wid = __builtin_amdgcn_readfirstlane(tid >> 6), lane = tid & 63, wr = wid >> 2, wc = wid & 3, fr = lane & 15, fq = lane >> 4;
    const int nt = K / BK;
    unsigned voffA[2]; int Rv[2], Cb[2];
#pragma unroll
    for (int i = 0; i < 2; ++i) { int R, C; stage_rc(tid * 16 + i * 8192, R, C); voffA[i] = (unsigned)(R * K + C) * 2u; Rv[i] = R; Cb[i] = C * 2; }
    unsigned coff[2][2], noff[2][2];
    auto load_off = [&](int arow, unsigned (&o)[2][2]) {
#pragma unroll
        for (int h = 0; h < 2; ++h)
#pragma unroll
            for (int i = 0; i < 2; ++i) { const int r = arow + h * 128 + Rv[i]; const int tok = (r >> 14) * SEQ + gidx[r]; o[h][i] = (unsigned)tok * (unsigned)(K * 2) + (unsigned)Cb[i]; }
    };
    const size_t kstep = (size_t)(BK * 2);
    const size_t hstep = (size_t)HALF * K * 2;
    const size_t rstep = (size_t)K * 2;
    const unsigned ldsw = (unsigned)wid * 1024u;
    const int aoff = lds_byte(wr * 64 + fr, fq * 8), boff = lds_byte(wc * 32 + fr, fq * 8);
#define PG8_SA(b, h) (((b) * 2 + (h)) * HTB)
#define PG8_SB(b, h) ((4 + (b) * 2 + (h)) * HTB)
#define PG8_STAGE(bufoff, gbase, voff) do { _Pragma("unroll") for (int _i = 0; _i < 2; ++_i) \
        __builtin_amdgcn_global_load_lds((const unsigned*)((const char*)(gbase) + (voff)[_i]), (LAS unsigned*)(lds + (bufoff) + ldsw + _i * 8192), 16, 0, 0); } while (0)
#define STG_A(bufoff, kb, h, usen) do { if constexpr (GATHER) { unsigned o_[2] = {(usen) ? noff[h][0] : coff[h][0], (usen) ? noff[h][1] : coff[h][1]}; PG8_STAGE(bufoff, (const char*)A + (kb), o_); } \
        else { PG8_STAGE(bufoff, ((usen) ? nA : cA) + (kb) + (size_t)(h) * hstep, voffA); } } while (0)
#define PG8_LDA(dst, b, h) do { _Pragma("unroll") for (int m = 0; m < 4; ++m) _Pragma("unroll") for (int k = 0; k < 2; ++k) dst[m][k] = *(const LAS bf16x8*)(lds + PG8_SA(b, h) + aoff + m * 2048 + k * 1024); } while (0)
#define PG8_LDB(dst, b, h) do { _Pragma("unroll") for (int n = 0; n < 2; ++n) _Pragma("unroll") for (int k = 0; k < 2; ++k) dst[n][k] = *(const LAS bf16x8*)(lds + PG8_SB(b, h) + boff + n * 2048 + k * 1024); } while (0)
#define PG8_MMA(ai, bj, At, Bt_) do { __builtin_amdgcn_s_setprio(1); _Pragma("unroll") for (int m = 0; m < 4; ++m) _Pragma("unroll") for (int n = 0; n < 2; ++n) _Pragma("unroll") for (int k = 0; k < 2; ++k) \
        acc[ai][bj][m][n] = __builtin_amdgcn_mfma_f32_16x16x32_bf16(Bt_[n][k], At[m][k], acc[ai][bj][m][n], 0, 0, 0); __builtin_amdgcn_s_setprio(0); } while (0)
#define PG8_WAIT_V(n) asm volatile("s_waitcnt vmcnt(" #n ")" ::: "memory")
#define PG8_WAIT_L(n) asm volatile("s_waitcnt lgkmcnt(" #n ")" ::: "memory")
#define PG8_BAR __builtin_amdgcn_s_barrier()
#define PG8_SCHED __builtin_amdgcn_sched_barrier(0)
    Unit cur, nxt; int ui = 0;
    if (!S.next(0, cur)) return;
    f32x4 acc[2][2][4][2];
#pragma unroll
    for (int a = 0; a < 2; ++a)
#pragma unroll
        for (int b = 0; b < 2; ++b)
#pragma unroll
            for (int m = 0; m < 4; ++m)
#pragma unroll
                for (int n = 0; n < 2; ++n) acc[a][b][m][n] = (f32x4){0.f, 0.f, 0.f, 0.f};
    bf16x8 At[4][2], B0[2][2], B1[2][2];
    const char* cA = (const char*)A + (size_t)cur.arow * rstep; const char* cB = (const char*)Bt + (size_t)cur.brow * rstep;
    const char* nA = cA;
    if constexpr (GATHER) { load_off(cur.arow, coff); }
    PG8_STAGE(PG8_SB(0, 0), cB, voffA); STG_A(PG8_SA(0, 0), (size_t)0, 0, false); PG8_STAGE(PG8_SB(0, 1), cB + hstep, voffA); STG_A(PG8_SA(0, 1), (size_t)0, 1, false);
    if (wr == 1) PG8_BAR;
    PG8_WAIT_V(4); PG8_BAR;
    PG8_STAGE(PG8_SB(1, 0), cB + kstep, voffA); STG_A(PG8_SA(1, 0), kstep, 0, false); PG8_STAGE(PG8_SB(1, 1), cB + hstep + kstep, voffA);
    PG8_WAIT_V(6); PG8_BAR;
    for (;;) {
        const bool has_next = S.next(ui + 1, nxt);
        nA = has_next ? (const char*)A + (size_t)nxt.arow * rstep : cA; const char* nB = has_next ? (const char*)Bt + (size_t)nxt.brow * rstep : cB;
        if constexpr (GATHER) { if (has_next) load_off(nxt.arow, noff); else {
#pragma unroll
            for (int h = 0; h < 2; ++h) { noff[h][0] = coff[h][0]; noff[h][1] = coff[h][1]; } } }
        for (int t = 0; t < nt; t += 2) {
            const bool last = (t == nt - 2);
            const size_t k1 = (size_t)(t + 1) * kstep, k2 = last ? (size_t)0 : (size_t)(t + 2) * kstep, k3 = k2 + kstep;
            const char* b2 = last ? nB : cB + (size_t)(t + 2) * kstep;
            const char* b3 = b2 + kstep;
            PG8_LDB(B0, 0, 0); PG8_SCHED; PG8_LDA(At, 0, 0); STG_A(PG8_SA(1, 1), k1, 1, false);
            PG8_WAIT_L(8); PG8_BAR; PG8_WAIT_L(0); PG8_MMA(0, 0, At, B0); PG8_BAR; PG8_SCHED;
            PG8_LDB(B1, 0, 1); PG8_STAGE(PG8_SB(0, 0), b2, voffA);
            PG8_BAR; PG8_WAIT_L(0); PG8_MMA(0, 1, At, B1); PG8_BAR;
            PG8_LDA(At, 0, 1); STG_A(PG8_SA(0, 0), k2, 0, last);
            PG8_BAR; PG8_WAIT_L(0); PG8_MMA(1, 0, At, B0); PG8_BAR; PG8_SCHED;
            PG8_STAGE(PG8_SB(0, 1), b2 + hstep, voffA);
            PG8_WAIT_V(6); PG8_BAR; PG8_MMA(1, 1, At, B1); PG8_BAR;
            PG8_LDB(B0, 1, 0); PG8_SCHED; PG8_LDA(At, 1, 0); STG_A(PG8_SA(0, 1), k2, 1, last);
            PG8_WAIT_L(8); PG8_BAR; PG8_WAIT_L(0); PG8_MMA(0, 0, At, B0); PG8_BAR; PG8_SCHED;
            PG8_LDB(B1, 1, 1); PG8_STAGE(PG8_SB(1, 0), b3, voffA);
            PG8_BAR; PG8_WAIT_L(0); PG8_MMA(0, 1, At, B1); PG8_BAR;
            PG8_LDA(At, 1, 1); STG_A(PG8_SA(1, 0), k3, 0, last);
            PG8_BAR; PG8_WAIT_L(0); PG8_MMA(1, 0, At, B0); PG8_BAR; PG8_SCHED;
            PG8_STAGE(PG8_SB(1, 1), b3 + hstep, voffA);
            PG8_WAIT_V(6); PG8_BAR; PG8_MMA(1, 1, At, B1); PG8_BAR;
        }
        E(acc, cur, wr, wc, fr, fq);
        if (!has_next) break;
#pragma unroll
        for (int a = 0; a < 2; ++a)
#pragma unroll
            for (int b = 0; b < 2; ++b)
#pragma unroll
                for (int m = 0; m < 4; ++m)
#pragma unroll
                    for (int n = 0; n < 2; ++n) acc[a][b][m][n] = (f32x4){0.f, 0.f, 0.f, 0.f};
        cur = nxt; cA = nA; cB = nB; ++ui;
        if constexpr (GATHER) {
#pragma unroll
            for (int h = 0; h < 2; ++h) { coff[h][0] = noff[h][0]; coff[h][1] = noff[h][1]; } }
    }
    PG8_WAIT_V(0);
    if (wr == 0) PG8_BAR;
    PG8_BAR;
#undef PG8_SA
#undef PG8_SB
#undef PG8_STAGE
#undef STG_A
#undef PG8_LDA
#undef PG8_LDB
#undef PG8_MMA
#undef PG8_WAIT_V
#undef PG8_WAIT_L
#undef PG8_BAR
#undef PG8_SCHED
}

typedef const f32x4 (&AccRef)[2][2][4][2];

struct EpiQKV0 {
    bf16_t* O; const float* qn; const float* kn;
    const float *rc, *rs, *cc, *cs, *sc, *ss;
    __device__ __forceinline__ void operator()(AccRef acc, const Unit& u, int wr, int wc, int fr, int fq) const {
        const int head = 4 * u.pn + wc;
        const int type = head < 10 ? 0 : ((head >= 12 && head < 22) ? 1 : 2);
        float gain[2][8];
        if (type == 0) { const float* gp = head < 8 ? qn : kn;
#pragma unroll
            for (int bj = 0; bj < 2; ++bj)
#pragma unroll
                for (int j = 0; j < 8; ++j) gain[bj][j] = gp[bj * 32 + (j & 1) * 16 + 4 * fq + (j >> 1)]; }
        const int rowb = u.orow + 64 * wr + fr;
        f32x4 tc[4] = {}, tn[4] = {};
        auto ldtab = [&](f32x4 (&t)[4], int g) {
            const int s = (rowb + 128 * (g >> 2) + 16 * (g & 3)) & (SEQ - 1);
            if (type == 0) { t[0] = *(const f32x4*)(rc + (s >> 6) * 16 + 4 * fq); t[1] = *(const f32x4*)(rs + (s >> 6) * 16 + 4 * fq);
                             t[2] = *(const f32x4*)(cc + (s & 63) * 16 + 4 * fq); t[3] = *(const f32x4*)(cs + (s & 63) * 16 + 4 * fq); }
            else { t[0] = *(const f32x4*)(sc + s * 32 + 4 * fq); t[1] = *(const f32x4*)(ss + s * 32 + 4 * fq);
                   t[2] = *(const f32x4*)(sc + s * 32 + 16 + 4 * fq); t[3] = *(const f32x4*)(ss + s * 32 + 16 + 4 * fq); }
        };
        if (type != 2) ldtab(tc, 0);
        const float qs = (head < 8 || (head >= 12 && head < 20)) ? 0.18033688011112042f : 1.f;
#pragma unroll
        for (int g = 0; g < 8; ++g) {
            const int ai = g >> 2, m = g & 3;
            const int row = rowb + 128 * ai + 16 * m;
            if (type != 2 && g + 1 < 8) ldtab(tn, g + 1);
            float v[2][8];
#pragma unroll
            for (int bj = 0; bj < 2; ++bj)
#pragma unroll
                for (int n = 0; n < 2; ++n)
#pragma unroll
                    for (int i = 0; i < 4; ++i) v[bj][4 * n + i] = acc[ai][bj][m][n][i];
            if (type == 0) {
                float sq = 0.f;
#pragma unroll
                for (int bj = 0; bj < 2; ++bj)
#pragma unroll
                    for (int j = 0; j < 8; ++j) sq += v[bj][j] * v[bj][j];
                sq += __shfl_xor(sq, 16); sq += __shfl_xor(sq, 32);
                const float rinv = rsqrtf(sq * (1.f / 64.f) + 1e-6f);
#pragma unroll
                for (int bj = 0; bj < 2; ++bj)
#pragma unroll
                    for (int j = 0; j < 8; ++j) v[bj][j] = v[bj][j] * rinv * gain[bj][j];
            }
            if (type != 2) {
#pragma unroll
                for (int bj = 0; bj < 2; ++bj) {
                    const f32x4 cv = tc[2 * bj], sv = tc[2 * bj + 1];
#pragma unroll
                    for (int jj = 0; jj < 4; ++jj) { const float x1 = v[bj][2 * jj], x2 = v[bj][2 * jj + 1];
                        v[bj][2 * jj] = x1 * cv[jj] - x2 * sv[jj]; v[bj][2 * jj + 1] = x2 * cv[jj] + x1 * sv[jj]; }
                }
            }
#pragma unroll
            for (int bj = 0; bj < 2; ++bj) {
                u32x4 w = {cvtpk(v[bj][0] * qs, v[bj][1] * qs), cvtpk(v[bj][2] * qs, v[bj][3] * qs), cvtpk(v[bj][4] * qs, v[bj][5] * qs), cvtpk(v[bj][6] * qs, v[bj][7] * qs)};
                *(u32x4*)(O + (size_t)row * 1536 + head * 64 + 32 * bj + 8 * fq) = w;
            }
#pragma unroll
            for (int k = 0; k < 4; ++k) tc[k] = tn[k];
        }
    }
};

struct EpiRes {
    const float* res; float* out;
    __device__ __forceinline__ void operator()(AccRef acc, const Unit& u, int wr, int wc, int fr, int fq) const {
        const size_t row0 = (size_t)(u.orow + 64 * wr + fr); const int col0 = 256 * u.pn + 32 * wc + 4 * fq;
        f32x4 rc[4], rn[4];
#pragma unroll
        for (int k = 0; k < 4; ++k) rc[k] = *(const f32x4*)(res + row0 * 1024 + col0 + 128 * (k >> 1) + 16 * (k & 1));
#pragma unroll
        for (int g = 0; g < 8; ++g) {
            const int ai = g >> 2, m = g & 3;
            if (g + 1 < 8) { const size_t rown = row0 + 128 * ((g + 1) >> 2) + 16 * ((g + 1) & 3);
#pragma unroll
                for (int k = 0; k < 4; ++k) rn[k] = *(const f32x4*)(res + rown * 1024 + col0 + 128 * (k >> 1) + 16 * (k & 1)); }
            const size_t row = row0 + 128 * ai + 16 * m;
#pragma unroll
            for (int k = 0; k < 4; ++k) *(f32x4*)(out + row * 1024 + col0 + 128 * (k >> 1) + 16 * (k & 1)) = rc[k] * ALPHA + acc[ai][k >> 1][m][k & 1];
#pragma unroll
            for (int k = 0; k < 4; ++k) rc[k] = rn[k];
        }
    }
};
struct EpiF32 {
    float* out; int ldc;
    __device__ __forceinline__ void operator()(AccRef acc, const Unit& u, int wr, int wc, int fr, int fq) const {
#pragma unroll
        for (int ai = 0; ai < 2; ++ai)
#pragma unroll
            for (int m = 0; m < 4; ++m) {
                const size_t row = (size_t)(u.orow + 128 * ai + 64 * wr + 16 * m + fr);
#pragma unroll
                for (int bj = 0; bj < 2; ++bj)
#pragma unroll
                    for (int n = 0; n < 2; ++n) {
                        const int col = 256 * u.pn + 128 * bj + 32 * wc + 16 * n + 4 * fq;
                        *(f32x4*)(out + row * ldc + col) = acc[ai][bj][m][n];
                    }
            }
    }
};
struct EpiSwiGLU {
    bf16_t* H;
    __device__ __forceinline__ void operator()(AccRef acc, const Unit& u, int wr, int wc, int fr, int fq) const {
#pragma unroll
        for (int ai = 0; ai < 2; ++ai)
#pragma unroll
            for (int m = 0; m < 4; ++m) {
                const size_t row = (size_t)(u.orow + 128 * ai + 64 * wr + 16 * m + fr);
                float h[8];
#pragma unroll
                for (int n = 0; n < 2; ++n)
#pragma unroll
                    for (int i = 0; i < 4; ++i) { const float g = acc[ai][0][m][n][i], up = acc[ai][1][m][n][i];
                        h[4 * n + i] = g * __builtin_amdgcn_rcpf(1.f + __builtin_amdgcn_exp2f(-g * 1.4426950408889634f)) * up; }
                u32x4 w = {cvtpk(h[0], h[1]), cvtpk(h[2], h[3]), cvtpk(h[4], h[5]), cvtpk(h[6], h[7])};
                *(u32x4*)(H + row * 1024 + 128 * u.pn + 32 * wc + 8 * fq) = w;
            }
    }
};
template <int MODE  >
struct EpiBf16 {
    bf16_t* O; int ldc; const float* rowscale; const float* mc; const float* ms;
    __device__ __forceinline__ void operator()(AccRef acc, const Unit& u, int wr, int wc, int fr, int fq) const {
        const int rowb = u.orow + 64 * wr + fr;
        float scv[8];
#pragma unroll
        for (int g = 0; g < 8; ++g) scv[g] = (MODE == 1) ? rowscale[(size_t)(rowb + 128 * (g >> 2) + 16 * (g & 3))] : (MODE == 2 ? 0.14724508409f : 1.f);
        bool rp[2] = {false, false};
        if (MODE == 2) { rp[0] = ((8 * u.pn + wc) % 3) == 2; rp[1] = ((8 * u.pn + 4 + wc) % 3) == 2; }
        const bool anyrope = (MODE == 2) && (rp[0] || rp[1]);
        f32x4 cvc = {}, svc = {}, cvn = {}, svn = {};
        if (anyrope) { const int s0 = rowb & (SEQ - 1); cvc = *(const f32x4*)(mc + s0 * 16 + 4 * fq); svc = *(const f32x4*)(ms + s0 * 16 + 4 * fq); }
#pragma unroll
        for (int g = 0; g < 8; ++g) {
            const int ai = g >> 2, m = g & 3;
            const int rowi = rowb + 128 * ai + 16 * m; const size_t row = (size_t)rowi;
            if (anyrope && g + 1 < 8) { const int sn = (rowb + 128 * ((g + 1) >> 2) + 16 * ((g + 1) & 3)) & (SEQ - 1);
                cvn = *(const f32x4*)(mc + sn * 16 + 4 * fq); svn = *(const f32x4*)(ms + sn * 16 + 4 * fq); }
            const float sc = scv[g];
#pragma unroll
            for (int bj = 0; bj < 2; ++bj) {
                float v[8];
#pragma unroll
                for (int n = 0; n < 2; ++n)
#pragma unroll
                    for (int i = 0; i < 4; ++i) v[4 * n + i] = acc[ai][bj][m][n][i] * sc;
                if (MODE == 2) {
                    if (rp[bj]) {
#pragma unroll
                        for (int jj = 0; jj < 4; ++jj) { const float x1 = v[2 * jj], x2 = v[2 * jj + 1];
                            v[2 * jj] = x1 * cvc[jj] - x2 * svc[jj]; v[2 * jj + 1] = x2 * cvc[jj] + x1 * svc[jj]; }
                    }
                }
                u32x4 w = {cvtpk(v[0], v[1]), cvtpk(v[2], v[3]), cvtpk(v[4], v[5]), cvtpk(v[6], v[7])};
                *(u32x4*)(O + row * ldc + 256 * u.pn + 128 * bj + 32 * wc + 8 * fq) = w;
            }
            cvc = cvn; svc = svn;
        }
    }
};

#define SBAR() __builtin_amdgcn_sched_barrier(0)
__device__ __forceinline__ int crow(int r, int hi) { return (r & 3) + 8 * (r >> 2) + 4 * hi; }
template <int DQ> struct ACfg {
    static constexpr int KROW = DQ * 2 + 16, SHM_K = 64 * KROW, SHM_V = 64 * 64 * 2, ND = DQ / 16;
    static constexpr float SCALE = DQ == 64 ? 0.125f : 0.10206207261596575f;
};
constexpr float ATT_THR = 8.f;

#ifndef ATT_GUARD
#define ATT_GUARD 1.0e30f
#endif
__device__ __forceinline__ void win_mask(f32x16& p0, f32x16& p1, int dlt, int hi) {
#pragma unroll
    for (int r = 0; r < 16; ++r) { const int d0 = dlt - crow(r, hi), d1 = d0 - 32;
        if (d0 > 128 || d0 < -128) p0[r] = -INFINITY;
        if (d1 > 128 || d1 < -128) p1[r] = -INFINITY; }
}
__device__ __forceinline__ float row_max32(const f32x16& p0, const f32x16& p1) {
    float pmax = p0[0];
#pragma unroll
    for (int r = 1; r < 16; ++r) pmax = fmaxf(pmax, p0[r]);
#pragma unroll
    for (int r = 0; r < 16; ++r) pmax = fmaxf(pmax, p1[r]);
    auto rr = __builtin_amdgcn_permlane32_swap(__float_as_uint(pmax), __float_as_uint(pmax), false, false);
    return fmaxf(__uint_as_float(rr[0]), __uint_as_float(rr[1]));
}
__device__ __forceinline__ float row_sum32_half(const f32x16& p0, const f32x16& p1) {
    float ps = 0;
#pragma unroll
    for (int r = 0; r < 16; ++r) ps += p0[r];
#pragma unroll
    for (int r = 0; r < 16; ++r) ps += p1[r];
    return ps;
}
__device__ __forceinline__ void exp16(f32x16& p) {
#pragma unroll
    for (int r = 0; r < 16; ++r) p[r] = __builtin_amdgcn_exp2f(p[r]);
}
__device__ __forceinline__ void pack_p(const f32x16& p0, const f32x16& p1, bf16x8& pa0, bf16x8& pa1, bf16x8& pa2, bf16x8& pa3) {
#define PK4(P, BASE, OUT) do { unsigned a0 = cvtpk(P[BASE + 0], P[BASE + 1]), a1 = cvtpk(P[BASE + 2], P[BASE + 3]);   \
    unsigned b0 = cvtpk(P[BASE + 4], P[BASE + 5]), b1 = cvtpk(P[BASE + 6], P[BASE + 7]);                              \
    auto r0 = __builtin_amdgcn_permlane32_swap(a0, b0, false, false); auto r1 = __builtin_amdgcn_permlane32_swap(a1, b1, false, false); \
    u32x4 w = {r0[0], r1[0], r0[1], r1[1]}; OUT = *reinterpret_cast<bf16x8*>(&w); } while (0)
    PK4(p0, 0, pa0); PK4(p0, 8, pa1); PK4(p1, 0, pa2); PK4(p1, 8, pa3);
#undef PK4
}
__device__ __forceinline__ void pack_p_ns(const f32x16& p0, const f32x16& p1, bf16x8& pa0, bf16x8& pa1, bf16x8& pa2, bf16x8& pa3) {
#define PK8(P, BASE, OUT) do { u32x4 w = {cvtpk(P[BASE + 0], P[BASE + 1]), cvtpk(P[BASE + 2], P[BASE + 3]), cvtpk(P[BASE + 4], P[BASE + 5]), cvtpk(P[BASE + 6], P[BASE + 7])}; \
    OUT = *reinterpret_cast<bf16x8*>(&w); } while (0)
    PK8(p0, 0, pa0); PK8(p0, 8, pa1); PK8(p1, 0, pa2); PK8(p1, 8, pa3);
#undef PK8
}
template <int DQ>
__device__ __forceinline__ void qkt(f32x16& p0, f32x16& p1, const char* Ks, const bf16x8* qr, const f32x16& ci, int r32, int hi) {
    constexpr int KROW = ACfg<DQ>::KROW, ND = ACfg<DQ>::ND;
    bf16x8 k0[ND], k1[ND];
#pragma unroll
    for (int d0 = 0; d0 < ND; ++d0) { const int cb = (d0 * 16 + hi * 8) * 2;
        k0[d0] = *reinterpret_cast<const bf16x8*>(Ks + r32 * KROW + cb);
        k1[d0] = *reinterpret_cast<const bf16x8*>(Ks + (32 + r32) * KROW + cb); }
    SBAR();
#pragma unroll
    for (int d0 = 0; d0 < ND; ++d0) {
        p0 = __builtin_amdgcn_mfma_f32_32x32x16_bf16(k0[d0], qr[d0], d0 == 0 ? ci : p0, 0, 0, 0);
        p1 = __builtin_amdgcn_mfma_f32_32x32x16_bf16(k1[d0], qr[d0], d0 == 0 ? ci : p1, 0, 0, 0); }
}
__device__ __forceinline__ int v_st(int k, int c) { const int kk = (k & ~0xC) | ((k & 4) << 1) | ((k & 8) >> 1); return ((kk >> 3) * 2 + (c >> 5)) * 512 + ((kk & 7) * 32 + (c & 31)) * 2; }
__device__ __forceinline__ int v_st_ns(int k, int c) { return ((k >> 3) * 2 + (c >> 5)) * 512 + ((k & 7) * 32 + (c & 31)) * 2; }
__device__ __forceinline__ int v_rd_base(int lane) { return ((lane & 3) << 3) | (((lane >> 2) & 3) << 6) | (((lane >> 4) & 1) << 5) | (((lane >> 5) & 1) << 8); }
constexpr int v_rd_off(int d0, int ks, int half) { return d0 * 512 + ks * 2048 + half * 1024; }
template <int OFF> __device__ __forceinline__ s16x4 tr_read(int vb) {
    s16x4 r; asm volatile("ds_read_b64_tr_b16 %0, %1 offset:%2" : "=&v"(r) : "v"(vb), "i"(OFF) : "memory"); return r;
}
template <int D0> __device__ __forceinline__ void pv_one(f32x16& od, int vb, bf16x8 pa0, bf16x8 pa1, bf16x8 pa2, bf16x8 pa3) {
    const s16x4 l0 = tr_read<v_rd_off(D0, 0, 0)>(vb), h0 = tr_read<v_rd_off(D0, 0, 1)>(vb), l1 = tr_read<v_rd_off(D0, 1, 0)>(vb), h1 = tr_read<v_rd_off(D0, 1, 1)>(vb);
    const s16x4 l2 = tr_read<v_rd_off(D0, 2, 0)>(vb), h2 = tr_read<v_rd_off(D0, 2, 1)>(vb), l3 = tr_read<v_rd_off(D0, 3, 0)>(vb), h3 = tr_read<v_rd_off(D0, 3, 1)>(vb);
    asm volatile("s_waitcnt lgkmcnt(0)" ::: "memory"); SBAR();
#define PK(L, H) (bf16x8){L[0], L[1], L[2], L[3], H[0], H[1], H[2], H[3]}
    od = __builtin_amdgcn_mfma_f32_32x32x16_bf16(pa0, PK(l0, h0), od, 0, 0, 0);
    od = __builtin_amdgcn_mfma_f32_32x32x16_bf16(pa1, PK(l1, h1), od, 0, 0, 0);
    od = __builtin_amdgcn_mfma_f32_32x32x16_bf16(pa2, PK(l2, h2), od, 0, 0, 0);
    od = __builtin_amdgcn_mfma_f32_32x32x16_bf16(pa3, PK(l3, h3), od, 0, 0, 0);
#undef PK
}
__device__ __forceinline__ void pv_d0(f32x16* o, int vb, bf16x8 pa0, bf16x8 pa1, bf16x8 pa2, bf16x8 pa3) {
    pv_one<0>(o[0], vb, pa0, pa1, pa2, pa3); pv_one<1>(o[1], vb, pa0, pa1, pa2, pa3);
}

template <int DQ, bool WIN>
__device__ __forceinline__ void partialSM_s(f32x16& p0, f32x16& p1, float& m_reg, float& mn, float& alpha, int dlt, int hi) {
    constexpr float C = 1.0f, SCALE = 1.0f / 1.4426950408889634f;
    if (WIN) {
#pragma unroll
        for (int r = 0; r < 16; ++r) { const int d0 = dlt - crow(r, hi), d1 = d0 - 32;
            if (d0 > 128 || d0 < -128) p0[r] = -INFINITY;
            if (d1 > 128 || d1 < -128) p1[r] = -INFINITY; }
    }
    float pmax = p0[0];
#pragma unroll
    for (int r = 1; r < 16; ++r) pmax = fmaxf(pmax, p0[r]);
#pragma unroll
    for (int r = 0; r < 16; ++r) pmax = fmaxf(pmax, p1[r]);
    { auto rr = __builtin_amdgcn_permlane32_swap(__float_as_uint(pmax), __float_as_uint(pmax), false, false);
      pmax = fmaxf(__uint_as_float(rr[0]), __uint_as_float(rr[1])); }
    if (__builtin_expect(__all(pmax - m_reg <= ATT_THR / SCALE), 1)) { mn = m_reg; alpha = 1.f; }
    else { mn = fmaxf(m_reg, pmax); alpha = __builtin_amdgcn_exp2f((m_reg - mn) * C); m_reg = mn; }
    const float mnC = -mn * C;
#pragma unroll
    for (int r = 0; r < 16; ++r) p0[r] = fmaf(p0[r], C, mnC);
#pragma unroll
    for (int r = 0; r < 16; ++r) p1[r] = fmaf(p1[r], C, mnC);
#pragma unroll
    for (int r = 0; r < 16; ++r) p0[r] = __builtin_amdgcn_exp2f(p0[r]);
}
__device__ __forceinline__ void finishSM_s(f32x16& p0, f32x16& p1, float alpha, float& l_reg, bf16x8& pa0, bf16x8& pa1, bf16x8& pa2, bf16x8& pa3) {
#pragma unroll
    for (int r = 0; r < 16; ++r) p1[r] = __builtin_amdgcn_exp2f(p1[r]);
    float ps = 0;
#pragma unroll
    for (int r = 0; r < 16; ++r) ps += p0[r];
#pragma unroll
    for (int r = 0; r < 16; ++r) ps += p1[r];
    { auto rr = __builtin_amdgcn_permlane32_swap(__float_as_uint(ps), __float_as_uint(ps), false, false);
      ps = __uint_as_float(rr[0]) + __uint_as_float(rr[1]); }
    l_reg = l_reg * alpha + ps;
#define PK4(P, BASE, OUT) do { unsigned a0 = cvtpk(P[BASE + 0], P[BASE + 1]), a1 = cvtpk(P[BASE + 2], P[BASE + 3]);   \
    unsigned b0 = cvtpk(P[BASE + 4], P[BASE + 5]), b1 = cvtpk(P[BASE + 6], P[BASE + 7]);                              \
    auto r0 = __builtin_amdgcn_permlane32_swap(a0, b0, false, false); auto r1 = __builtin_amdgcn_permlane32_swap(a1, b1, false, false); \
    u32x4 w = {r0[0], r1[0], r0[1], r1[1]}; OUT = *reinterpret_cast<bf16x8*>(&w); } while (0)
    PK4(p0, 0, pa0); PK4(p0, 8, pa1); PK4(p1, 0, pa2); PK4(p1, 8, pa3);
#undef PK4
}
template <int DQ>
__device__ __forceinline__ void qkt_s(f32x16& p0, f32x16& p1, const char* Ks, const bf16x8* qr, int r32, int hi) {
    constexpr int KROW = ACfg<DQ>::KROW;
    p0 = f32x16{}; p1 = f32x16{};
#pragma unroll
    for (int d0 = 0; d0 < ACfg<DQ>::ND; ++d0) { const int cb = (d0 * 16 + hi * 8) * 2;
        bf16x8 b0 = *reinterpret_cast<const bf16x8*>(Ks + r32 * KROW + cb);
        bf16x8 b1 = *reinterpret_cast<const bf16x8*>(Ks + (32 + r32) * KROW + cb);
        p0 = __builtin_amdgcn_mfma_f32_32x32x16_bf16(b0, qr[d0], p0, 0, 0, 0);
        p1 = __builtin_amdgcn_mfma_f32_32x32x16_bf16(b1, qr[d0], p1, 0, 0, 0); }
}

template <int DQ, bool WIN, int LDQ, int LDK>
__device__ __forceinline__ void attn_body_safe(const bf16_t* __restrict__ Qb, const bf16_t* __restrict__ Kh, const bf16_t* __restrict__ Kr, const bf16_t* __restrict__ Vh,
                                          bf16_t* __restrict__ Ob, int kt0, int NT, int q0, float sink_l2, char* lds) {
    constexpr int KROW = ACfg<DQ>::KROW, SHM_K = ACfg<DQ>::SHM_K, SHM_V = ACfg<DQ>::SHM_V, ND = ACfg<DQ>::ND;
    constexpr int LDO = 1024;
    constexpr float C = 1.0f;
    const int tid = otid(), wid = __builtin_amdgcn_readfirstlane(tid >> 6), lane = tid & 63, r32 = lane & 31, hi = lane >> 5;
    char* V_lds = lds; char* K_lds = lds + 2 * SHM_V;
    float* wsf = (float*)(lds + 2 * SHM_V + 2 * SHM_K) + wid * 64; float* li_l = wsf; float* al_l = wsf + 32;
    float m_reg = -1e30f, l_reg = 0; f32x16 o[2] = {}; bf16x8 qr[ND];
    const bf16_t* Qw = Qb + (size_t)(wid * 32 + r32) * LDQ + hi * 8;
#pragma unroll
    for (int d0 = 0; d0 < ND; ++d0) qr[d0] = *reinterpret_cast<const bf16x8*>(Qw + d0 * 16);
    const int sr = tid >> 3, sc = (tid & 7) * 8, vst0 = v_st(sr, sc);
    const int kst0 = sr * KROW + sc * 2;
    const int sr2 = (tid & 255) >> 2, sc2 = (tid & 3) * 8; const int kst2 = sr2 * KROW + 128 + sc2 * 2;
    const int vb0 = (int)(uintptr_t)V_lds + v_rd_base(lane);
    const int qrow = q0 + wid * 32 + r32;
    struct { bf16x8 vs, ks, kr; } st_[2];
#define SLOAD(i, k0) do { st_[i].vs = *reinterpret_cast<const bf16x8*>(&Vh[(size_t)((k0) + sr) * LDK + sc]); \
    st_[i].ks = *reinterpret_cast<const bf16x8*>(&Kh[(size_t)((k0) + sr) * LDK + sc]); \
    if (DQ == 96) st_[i].kr = *reinterpret_cast<const bf16x8*>(&Kr[(size_t)((k0) + sr2) * 32 + sc2]); } while (0)
#define SWRITE(b, i) do { *(bf16x8*)(V_lds + (b) * SHM_V + vst0) = st_[i].vs; *(bf16x8*)(K_lds + (b) * SHM_K + kst0) = st_[i].ks; \
    if (DQ == 96) { if (tid < 256) *(bf16x8*)(K_lds + (b) * SHM_K + kst2) = st_[i].kr; } } while (0)
#define SWAIT() do { if (DQ == 96) asm volatile("s_waitcnt vmcnt(3)" ::: "memory"); else asm volatile("s_waitcnt vmcnt(2)" ::: "memory"); } while (0)
#define RESC(a) do { if (__any((a) < 1.f)) { if (hi == 0) al_l[r32] = (a); asm volatile("s_waitcnt lgkmcnt(0)" ::: "memory"); \
    _Pragma("unroll") for (int d = 0; d < 2; ++d) _Pragma("unroll") for (int r = 0; r < 16; ++r) o[d][r] *= al_l[crow(r, hi)]; } } while (0)
#define KBASE(j) ((kt0 + (j)) * 64)
    f32x16 pA0, pA1, pB0, pB1; float mnA, mnB, alA, alB; bf16x8 pa0, pa1, pa2, pa3;
    constexpr int SE = 0, SO = 1;
    SLOAD(SE, KBASE(0)); asm volatile("s_waitcnt vmcnt(0)" ::: "memory"); SWRITE(0, SE); __syncthreads();
    qkt_s<DQ>(pA0, pA1, K_lds, qr, r32, hi); partialSM_s<DQ, WIN>(pA0, pA1, m_reg, mnA, alA, qrow - KBASE(0), hi);
    SLOAD(SO, KBASE(1)); if (2 < NT) SLOAD(SE, KBASE(2));
    SWAIT(); SWRITE(1, SO); __syncthreads();
    for (int j = 1; j + 1 < NT; j += 2) {
        SBAR(); qkt_s<DQ>(pB0, pB1, K_lds + SHM_K, qr, r32, hi);
        finishSM_s(pA0, pA1, alA, l_reg, pa0, pa1, pa2, pa3); SBAR();
        SLOAD(SO, KBASE(j + 2)); SBAR();
        pv_d0(o, vb0, pa0, pa1, pa2, pa3); partialSM_s<DQ, WIN>(pB0, pB1, m_reg, mnB, alB, qrow - KBASE(j), hi);
        __syncthreads(); SWAIT(); SWRITE(0, SE);
        RESC(alB); __syncthreads();
        SBAR(); qkt_s<DQ>(pA0, pA1, K_lds, qr, r32, hi);
        finishSM_s(pB0, pB1, alB, l_reg, pa0, pa1, pa2, pa3); SBAR();
        if (j + 3 < NT) SLOAD(SE, KBASE(j + 3)); SBAR();
        pv_d0(o, vb0 + SHM_V, pa0, pa1, pa2, pa3); partialSM_s<DQ, WIN>(pA0, pA1, m_reg, mnA, alA, qrow - KBASE(j + 1), hi);
        __syncthreads(); SWAIT(); SWRITE(1, SO);
        RESC(alA); __syncthreads();
    }
    SBAR(); qkt_s<DQ>(pB0, pB1, K_lds + SHM_K, qr, r32, hi);
    finishSM_s(pA0, pA1, alA, l_reg, pa0, pa1, pa2, pa3); SBAR();
    pv_d0(o, vb0, pa0, pa1, pa2, pa3); partialSM_s<DQ, WIN>(pB0, pB1, m_reg, mnB, alB, qrow - KBASE(NT - 1), hi);
    __syncthreads(); RESC(alB);
    finishSM_s(pB0, pB1, alB, l_reg, pa0, pa1, pa2, pa3); SBAR();
    pv_d0(o, vb0 + SHM_V, pa0, pa1, pa2, pa3);
    if (WIN) l_reg += __builtin_amdgcn_exp2f(sink_l2 - m_reg * C);
    if (hi == 0) li_l[r32] = l_reg; asm volatile("s_waitcnt lgkmcnt(0)" ::: "memory");
    float rli[16];
#pragma unroll
    for (int r = 0; r < 16; ++r) rli[r] = __builtin_amdgcn_rcpf(li_l[crow(r, hi)]);
    bf16_t* Ow = Ob + (size_t)(wid * 32) * LDO;
#pragma unroll
    for (int r = 0; r < 16; ++r) { const int orow = crow(r, hi);
#pragma unroll
        for (int d0 = 0; d0 < 2; ++d0) Ow[(size_t)orow * LDO + d0 * 32 + r32] = (bf16_t)(cvtpk(o[d0][r] * rli[r], 0.f) & 0xffffu); }
    __syncthreads();
#undef SLOAD
#undef SWRITE
#undef SWAIT
#undef RESC
#undef KBASE
}


template <int DQ, bool WIN, int LDQ, int LDK>
__device__ __forceinline__ int attn_body(const bf16_t* __restrict__ Qb, const bf16_t* __restrict__ Kh, const bf16_t* __restrict__ Kr, const bf16_t* __restrict__ Vh,
                                          bf16_t* __restrict__ Ob, int kt0, int NT, int q0, float sink_l2, char* lds) {
    constexpr int KROW = ACfg<DQ>::KROW, SHM_K = ACfg<DQ>::SHM_K, SHM_V = ACfg<DQ>::SHM_V, ND = ACfg<DQ>::ND;
    constexpr int LDO = 1024;
    const int tid = otid(), wid = __builtin_amdgcn_readfirstlane(tid >> 6), lane = tid & 63, r32 = lane & 31, hi = lane >> 5;
    char* V_lds = lds; char* K_lds = lds + 2 * SHM_V;
    float* wsf = (float*)(lds + 2 * SHM_V + 2 * SHM_K) + wid * 64; float* li_l = wsf;
    volatile int* redo_flag = (volatile int*)(lds + 2 * SHM_V + 2 * SHM_K + 8 * 64 * 4);
    if (tid == 0) *redo_flag = 0;
    float m_ref = 0.f; f32x16 o[2] = {}; f32x16 lsum = {}; f32x16 minit; bf16x8 qr[ND];
    const bf16x8 ones8 = {(short)0x3F80, (short)0x3F80, (short)0x3F80, (short)0x3F80, (short)0x3F80, (short)0x3F80, (short)0x3F80, (short)0x3F80};
    const f32x16 zero16 = {};
    const bf16_t* Qw = Qb + (size_t)(wid * 32 + r32) * LDQ + hi * 8;
#pragma unroll
    for (int d0 = 0; d0 < ND; ++d0) qr[d0] = *reinterpret_cast<const bf16x8*>(Qw + d0 * 16);
    const int sr = tid >> 3, sc = (tid & 7) * 8, vst0 = v_st_ns(sr, sc);
    const int kst0 = sr * KROW + sc * 2;
    const int sr2 = (tid & 255) >> 2, sc2 = (tid & 3) * 8; const int kst2 = sr2 * KROW + 128 + sc2 * 2;
    const int vb0 = (int)(uintptr_t)V_lds + v_rd_base(lane);
    const int qrow = q0 + wid * 32 + r32;
    struct { bf16x8 vs, ks, kr; } st_[2];
#define SLOAD(i, k0) do { st_[i].vs = *reinterpret_cast<const bf16x8*>(&Vh[(size_t)((k0) + sr) * LDK + sc]); \
    st_[i].ks = *reinterpret_cast<const bf16x8*>(&Kh[(size_t)((k0) + sr) * LDK + sc]); \
    if (DQ == 96) st_[i].kr = *reinterpret_cast<const bf16x8*>(&Kr[(size_t)((k0) + sr2) * 32 + sc2]); } while (0)
#define SWRITE(b, i) do { *(bf16x8*)(V_lds + (b) * SHM_V + vst0) = st_[i].vs; *(bf16x8*)(K_lds + (b) * SHM_K + kst0) = st_[i].ks; \
    if (DQ == 96) { if (tid < 256) *(bf16x8*)(K_lds + (b) * SHM_K + kst2) = st_[i].kr; } } while (0)
#define SWAIT() do { if (DQ == 96) asm volatile("s_waitcnt vmcnt(3)" ::: "memory"); else asm volatile("s_waitcnt vmcnt(2)" ::: "memory"); } while (0)
#define KBASE(j) ((kt0 + (j)) * 64)
    f32x16 pA0, pA1, pB0, pB1; bf16x8 pa0, pa1, pa2, pa3;
    auto finish = [&](f32x16& p0, f32x16& p1) {
        exp16(p1);
        pack_p_ns(p0, p1, pa0, pa1, pa2, pa3);
    };
    auto pv = [&](int vb) {
        pv_d0(o, vb, pa0, pa1, pa2, pa3);
    };
    auto lsum_upd = [&]() {
        lsum = __builtin_amdgcn_mfma_f32_32x32x16_bf16(pa0, ones8, lsum, 0, 0, 0);
        lsum = __builtin_amdgcn_mfma_f32_32x32x16_bf16(pa1, ones8, lsum, 0, 0, 0);
        lsum = __builtin_amdgcn_mfma_f32_32x32x16_bf16(pa2, ones8, lsum, 0, 0, 0);
        lsum = __builtin_amdgcn_mfma_f32_32x32x16_bf16(pa3, ones8, lsum, 0, 0, 0);
    };
    constexpr int SE = 0, SO = 1;
    SLOAD(SE, KBASE(0)); SLOAD(SO, KBASE(1));
    SWAIT(); SWRITE(0, SE); __syncthreads();
    qkt<DQ>(pA0, pA1, K_lds, qr, zero16, r32, hi);
    if (WIN) win_mask(pA0, pA1, qrow - KBASE(0), hi);
    { const float pm = row_max32(pA0, pA1); m_ref = (pm > -1e37f) ? pm : 0.f;
#pragma unroll
      for (int r = 0; r < 16; ++r) { minit[r] = -m_ref; pA0[r] -= m_ref; pA1[r] -= m_ref; } }
    exp16(pA0);
    if (2 < NT) SLOAD(SE, KBASE(2));
    SWAIT(); SWRITE(1, SO); __syncthreads();
#pragma unroll 1
    for (int j = 1; j + 1 < NT; j += 2) {
        SBAR(); qkt<DQ>(pB0, pB1, K_lds + SHM_K, qr, minit, r32, hi);
        finish(pA0, pA1); SBAR();
        SLOAD(SO, KBASE(j + 2)); SBAR();
        pv(vb0);
        __syncthreads(); SWAIT(); SWRITE(0, SE);
        lsum_upd();
        if (WIN) win_mask(pB0, pB1, qrow - KBASE(j), hi);
        exp16(pB0);
        __syncthreads();
        SBAR(); qkt<DQ>(pA0, pA1, K_lds, qr, minit, r32, hi);
        finish(pB0, pB1); SBAR();
        if (j + 3 < NT) SLOAD(SE, KBASE(j + 3)); SBAR();
        pv(vb0 + SHM_V);
        __syncthreads(); SWAIT(); SWRITE(1, SO);
        lsum_upd();
        if (WIN) win_mask(pA0, pA1, qrow - KBASE(j + 1), hi);
        exp16(pA0);
        __syncthreads();
    }
    SBAR(); qkt<DQ>(pB0, pB1, K_lds + SHM_K, qr, minit, r32, hi);
    finish(pA0, pA1); SBAR();
    pv(vb0); lsum_upd();
    if (WIN) win_mask(pB0, pB1, qrow - KBASE(NT - 1), hi);
    exp16(pB0);
    finish(pB0, pB1); SBAR();
    pv(vb0 + SHM_V); lsum_upd();
    if (WIN) {
        if (hi == 0) li_l[r32] = m_ref; asm volatile("s_waitcnt lgkmcnt(0)" ::: "memory");
#pragma unroll
        for (int r = 0; r < 16; ++r) lsum[r] += __builtin_amdgcn_exp2f(sink_l2 - li_l[crow(r, hi)]);
    }
    float rli[16]; bool fin = true;
#pragma unroll
    for (int r = 0; r < 16; ++r) { fin = fin && (lsum[r] < ATT_GUARD) && (lsum[r] > 0.f); rli[r] = __builtin_amdgcn_rcpf(lsum[r]); }
    if (!__all(fin)) { if (lane == 0) *redo_flag = 1; }
    bf16_t* Ow = Ob + (size_t)(wid * 32) * LDO;
#pragma unroll
    for (int r = 0; r < 16; ++r) { const int orow = crow(r, hi);
#pragma unroll
        for (int d0 = 0; d0 < 2; ++d0) Ow[(size_t)orow * LDO + d0 * 32 + r32] = (bf16_t)(cvtpk(o[d0][r] * rli[r], 0.f) & 0xffffu); }
    __syncthreads();
    const int redo = __builtin_amdgcn_readfirstlane(*redo_flag);
    __syncthreads();
    return redo;
#undef SLOAD
#undef SWRITE
#undef SWAIT
#undef KBASE
}

__device__ __forceinline__ void phase_attn0(const Params& p, char* lds) {
    const bf16_t* proj = (const bf16_t*)(p.ws + WS_PROJ); bf16_t* att = (bf16_t*)(p.ws + WS_ATT0);
    const float* sink = p.in[4];
    for (int it = blockIdx.x; it < 4096; it += gridDim.x) {
        const int win = it >> 11, r = it & 2047, b = r >> 8, hq = (r >> 5) & 7, qb = r & 31, kvh = hq >> 2;
        const size_t tok0 = (size_t)b * SEQ; const int q0 = qb * 256;
        if (!win) {
            if (attn_body<64, false, 1536, 1536>(proj + (tok0 + q0) * 1536 + hq * 64, proj + tok0 * 1536 + 512 + kvh * 64, nullptr, proj + tok0 * 1536 + 640 + kvh * 64,
                                             att + (tok0 + q0) * 1024 + hq * 64, 0, 128, q0, 0.f, lds))
                attn_body_safe<64, false, 1536, 1536>(proj + (tok0 + q0) * 1536 + hq * 64, proj + tok0 * 1536 + 512 + kvh * 64, nullptr, proj + tok0 * 1536 + 640 + kvh * 64,
                                             att + (tok0 + q0) * 1024 + hq * 64, 0, 128, q0, 0.f, lds);
        } else {
            int t0 = q0 / 64 - 2, t1 = q0 / 64 + 6; if (t0 < 0) t0 = 0; if (t1 > 128) t1 = 128;
            if (attn_body<64, true, 1536, 1536>(proj + (tok0 + q0) * 1536 + 768 + hq * 64, proj + tok0 * 1536 + 1280 + kvh * 64, nullptr, proj + tok0 * 1536 + 1408 + kvh * 64,
                                            att + (tok0 + q0) * 1024 + 512 + hq * 64, t0, t1 - t0, q0, sink[hq] * 1.4426950408889634f, lds))
                attn_body_safe<64, true, 1536, 1536>(proj + (tok0 + q0) * 1536 + 768 + hq * 64, proj + tok0 * 1536 + 1280 + kvh * 64, nullptr, proj + tok0 * 1536 + 1408 + kvh * 64,
                                            att + (tok0 + q0) * 1024 + 512 + hq * 64, t0, t1 - t0, q0, sink[hq] * 1.4426950408889634f, lds);
        }
    }
}
__device__ __forceinline__ void phase_attn1(const Params& p, char* lds) {
    const bf16_t* q = (const bf16_t*)(p.ws + WS_Q); const bf16_t* kv = (const bf16_t*)(p.ws + WS_KV); const bf16_t* kr = (const bf16_t*)(p.ws + WS_KR);
    bf16_t* att = (bf16_t*)(p.ws + WS_ATT1);
    for (int it = blockIdx.x; it < 4096; it += gridDim.x) {
        const int b = it >> 9, h = (it >> 5) & 15, qb = it & 31;
        const size_t tok0 = (size_t)b * SEQ; const int q0 = qb * 256;
        if (attn_body<96, false, 1536, 2048>(q + (tok0 + q0) * 1536 + h * 96, kv + tok0 * 2048 + h * 128, kr + tok0 * 32, kv + tok0 * 2048 + h * 128 + 64,
                                         att + (tok0 + q0) * 1024 + h * 64, 0, 128, q0, 0.f, lds))
            attn_body_safe<96, false, 1536, 2048>(q + (tok0 + q0) * 1536 + h * 96, kv + tok0 * 2048 + h * 128, kr + tok0 * 32, kv + tok0 * 2048 + h * 128 + 64,
                                         att + (tok0 + q0) * 1024 + h * 64, 0, 128, q0, 0.f, lds);
    }
}

__device__ __forceinline__ void phase_ln1(const Params& p, int layer, unsigned char* lds) {
    float* wrt = (float*)lds;
    const float* wr = p.in[14] + (size_t)layer * 1024 * 16;
    for (int i = otid(); i < 16384; i += 512) { const int c = i >> 4, e = i & 15; wrt[e * 1024 + c] = wr[i]; }
    __syncthreads();
    const int tid_ = otid(); const int wid = __builtin_amdgcn_readfirstlane(tid_ >> 6), lane = tid_ & 63;
    const float* g = p.in[12] + layer * 1024; const float* bb = p.in[13] + layer * 1024;
    f32x4 gv[4], bv[4];
#pragma unroll
    for (int j = 0; j < 4; ++j) { gv[j] = *(const f32x4*)(g + j * 256 + lane * 4); bv[j] = *(const f32x4*)(bb + j * 256 + lane * 4); }
    bf16_t* xb = (bf16_t*)(p.ws + WS_XB); float* aff = (float*)(p.ws + WS_AFF); f32x2* stats = (f32x2*)(p.ws + WS_STATS);
    const float* outp = p.out;
    auto process = [&](f32x4 (&v)[4], int t) {
        float s = 0.f;
#pragma unroll
        for (int j = 0; j < 4; ++j) s += v[j][0] + v[j][1] + v[j][2] + v[j][3];
        const float mu = wave_sum(s) * (1.f / 1024.f);
        float q = 0.f;
#pragma unroll
        for (int j = 0; j < 4; ++j)
#pragma unroll
            for (int i = 0; i < 4; ++i) { const float d = v[j][i] - mu; q += d * d; }
        const float rstd = rsqrtf(wave_sum(q) * (1.f / 1024.f) + 1e-5f);
        if (lane == 0) stats[t] = (f32x2){mu, rstd};
#pragma unroll
        for (int j = 0; j < 4; ++j) {
#pragma unroll
            for (int i = 0; i < 4; ++i) v[j][i] = (v[j][i] - mu) * rstd * gv[j][i] + bv[j][i];
            u32x2 w = {cvtpk(v[j][0], v[j][1]), cvtpk(v[j][2], v[j][3])};
            *(u32x2*)(xb + (size_t)t * 1024 + j * 256 + lane * 4) = w;
        }
        float lg[16];
#pragma unroll
        for (int e = 0; e < 16; ++e) {
            float a = 0.f;
#pragma unroll
            for (int j = 0; j < 4; ++j) { const f32x4 w = *(const f32x4*)(wrt + e * 1024 + j * 256 + lane * 4);
                a += v[j][0] * w[0] + v[j][1] * w[1] + v[j][2] * w[2] + v[j][3] * w[3]; }
            lg[e] = wave_sum(a);
        }
        float mx = lg[0];
#pragma unroll
        for (int e = 1; e < 16; ++e) mx = fmaxf(mx, lg[e]);
        float den = 0.f;
#pragma unroll
        for (int e = 0; e < 16; ++e) { lg[e] = __expf(lg[e] - mx); den += lg[e]; }
        const float rden = 1.f / den;
        float mine = 0.f;
#pragma unroll
        for (int e = 0; e < 16; ++e) mine = (lane == e) ? lg[e] * rden : mine;
        const int b = t >> 13, sidx = t & (SEQ - 1);
        if (lane < 16) aff[((size_t)(b * 16 + lane)) * SEQ + sidx] = mine;
    };
    auto loadrow = [&](f32x4 (&d)[4], int t) {
        const float* r = outp + (size_t)t * 1024 + lane * 4;
#pragma unroll
        for (int j = 0; j < 4; ++j) d[j] = *(const f32x4*)(r + j * 256);
    };
    const int st = gridDim.x * 8, t0 = blockIdx.x * 8 + wid;
    f32x4 A_[4], B_[4], v[4];
    loadrow(A_, t0); if (t0 + st < T_TOK) loadrow(B_, t0 + st);
    for (int t = t0; t < T_TOK; t += 2 * st) {
#pragma unroll
        for (int j = 0; j < 4; ++j) v[j] = A_[j];
        if (t + 2 * st < T_TOK) loadrow(A_, t + 2 * st);
        process(v, t);
        if (t + st < T_TOK) {
#pragma unroll
            for (int j = 0; j < 4; ++j) v[j] = B_[j];
            if (t + 3 * st < T_TOK) loadrow(B_, t + 3 * st);
            process(v, t + st);
        }
    }
    __syncthreads();
}

__device__ __forceinline__ void phase_topk(const Params& p, unsigned char* lds) {
    unsigned* red = (unsigned*)lds;
    const int tid = otid(), wid = __builtin_amdgcn_readfirstlane(tid >> 6), lane = tid & 63;
    const float* aff = (const float*)(p.ws + WS_AFF);
    int* idx = (int*)(p.ws + WS_IDX); float* gate = (float*)(p.ws + WS_GATE); int* slot = (int*)(p.ws + WS_SLOT);
    for (int be = blockIdx.x; be < 128; be += gridDim.x) {
        const int b = be >> 4, e = be & 15;
        const float* a = aff + (size_t)be * SEQ + tid * 16;
        unsigned v[16];
#pragma unroll
        for (int j = 0; j < 4; ++j) { const f32x4 x = *(const f32x4*)(a + j * 4);
#pragma unroll
            for (int i = 0; i < 4; ++i) v[j * 4 + i] = __float_as_uint(x[i]); }
        unsigned T = 0;
        for (int bit = 30; bit >= 0; --bit) {
            const unsigned cand = T | (1u << bit);
            unsigned cnt = 0;
#pragma unroll
            for (int j = 0; j < 16; ++j) cnt += (unsigned)__builtin_popcountll(__ballot(v[j] >= cand));
            unsigned* rb = red + (bit & 1) * 8;
            if (lane == 0) rb[wid] = cnt;
            __syncthreads();
            unsigned tot = 0;
#pragma unroll
            for (int w = 0; w < 8; ++w) tot += rb[w];
            if (tot >= 1024u) T = cand;
        }
        __syncthreads();
        unsigned cg_ = 0, ce_ = 0;
#pragma unroll
        for (int j = 0; j < 16; ++j) { cg_ += (v[j] > T) ? 1u : 0u; ce_ += (v[j] == T) ? 1u : 0u; }
        unsigned pk = cg_ | (ce_ << 16), incl = pk;
#pragma unroll
        for (int o = 1; o < 64; o <<= 1) { const unsigned y = __shfl_up(incl, o); if (lane >= o) incl += y; }
        unsigned* sb = red + 32;
        if (lane == 63) sb[wid] = incl;
        __syncthreads();
        unsigned wbase = 0, total = 0;
#pragma unroll
        for (int w = 0; w < 8; ++w) { const unsigned x = sb[w]; if (w < wid) wbase += x; total += x; }
        unsigned excl = wbase + incl - pk;
        unsigned ngt = excl & 0xffffu, neq = excl >> 16;
        const unsigned need_eq = 1024u - (total & 0xffffu);
#pragma unroll
        for (int j = 0; j < 16; ++j) {
            const int tkn = tid * 16 + j;
            const bool isg = v[j] > T, ise = v[j] == T;
            const bool sel = isg || (ise && neq < need_eq);
            const unsigned sl = ngt + (neq < need_eq ? neq : need_eq);
            if (sel) { idx[be * 1024 + sl] = tkn; gate[be * 1024 + sl] = __uint_as_float(v[j]); }
            slot[((size_t)(b * SEQ + tkn)) * 16 + e] = sel ? (int)sl : -1;
            ngt += isg ? 1u : 0u; neq += ise ? 1u : 0u;
        }
        __syncthreads();
    }
}

__device__ __forceinline__ void phase_gather(const Params& p) {
    const int tid_ = otid(); const int wid = __builtin_amdgcn_readfirstlane(tid_ >> 6), lane = tid_ & 63;
    const int* idx = (const int*)(p.ws + WS_IDX); const bf16_t* xb = (const bf16_t*)(p.ws + WS_XB); bf16_t* xg = (bf16_t*)(p.ws + WS_XG);
    for (int r = blockIdx.x * 8 + wid; r < 131072; r += gridDim.x * 8) {
        const int b = r >> 14; const int tk = idx[r];
        const u32x4* src = (const u32x4*)(xb + ((size_t)b * SEQ + tk) * 1024); u32x4* dst = (u32x4*)(xg + (size_t)r * 1024);
        const u32x4 a0 = src[lane], a1 = src[64 + lane];
        dst[lane] = a0; dst[64 + lane] = a1;
    }
}

__device__ __forceinline__ void phase_ln2(const Params& p, int layer, bool write_xb) {
    const int tid_ = otid(); const int wid = __builtin_amdgcn_readfirstlane(tid_ >> 6), lane = tid_ & 63;
    const float* g = p.in[18] + layer * 1024; const float* bb = p.in[19] + layer * 1024;
    const float* g1 = p.in[12] + layer * 1024; const float* b1 = p.in[13] + layer * 1024;
    f32x4 gv[4], bv[4], g1v[4], b1v[4];
#pragma unroll
    for (int j = 0; j < 4; ++j) { gv[j] = *(const f32x4*)(g + j * 256 + lane * 4); bv[j] = *(const f32x4*)(bb + j * 256 + lane * 4);
        g1v[j] = *(const f32x4*)(g1 + j * 256 + lane * 4); b1v[j] = *(const f32x4*)(b1 + j * 256 + lane * 4); }
    bf16_t* xb = (bf16_t*)(p.ws + WS_XB); const int* slot = (const int*)(p.ws + WS_SLOT); const bf16_t* y = (const bf16_t*)(p.ws + WS_Y);
    const f32x2* stats = (const f32x2*)(p.ws + WS_STATS);
    float* outp = p.out;
    auto process = [&](f32x4 (&v)[4], int myslot, f32x2 stt, int t) {
        float* row = outp + (size_t)t * 1024;
        const int b = t >> 13;
#pragma unroll
        for (int j = 0; j < 4; ++j)
#pragma unroll
            for (int i = 0; i < 4; ++i) v[j][i] = ((v[j][i] - stt[0]) * stt[1] * g1v[j][i] + b1v[j][i]) * ALPHA;
        unsigned long long em = __ballot(myslot >= 0 && lane < 16);
        while (em) {
            const int e0 = __builtin_ctzll(em); em &= em - 1;
            const bool two = em != 0ull;
            const int e1 = two ? __builtin_ctzll(em) : e0; if (two) em &= em - 1;
            const int s0 = __builtin_amdgcn_readlane(myslot, e0), s1 = __builtin_amdgcn_readlane(myslot, e1);
            const bf16_t* y0 = y + ((size_t)((b * 16 + e0) * 1024 + s0)) * 1024 + lane * 4;
            const bf16_t* y1 = y + ((size_t)((b * 16 + e1) * 1024 + s1)) * 1024 + lane * 4;
            u32x2 w0[4], w1[4];
#pragma unroll
            for (int j = 0; j < 4; ++j) { w0[j] = *(const u32x2*)(y0 + j * 256); w1[j] = *(const u32x2*)(y1 + j * 256); }
            const float f1 = two ? 1.f : 0.f;
#pragma unroll
            for (int j = 0; j < 4; ++j) {
                v[j][0] += __uint_as_float(w0[j][0] << 16); v[j][1] += __uint_as_float(w0[j][0] & 0xffff0000u);
                v[j][2] += __uint_as_float(w0[j][1] << 16); v[j][3] += __uint_as_float(w0[j][1] & 0xffff0000u);
                v[j][0] += f1 * __uint_as_float(w1[j][0] << 16); v[j][1] += f1 * __uint_as_float(w1[j][0] & 0xffff0000u);
                v[j][2] += f1 * __uint_as_float(w1[j][1] << 16); v[j][3] += f1 * __uint_as_float(w1[j][1] & 0xffff0000u);
            }
        }
        float s = 0.f;
#pragma unroll
        for (int j = 0; j < 4; ++j) s += v[j][0] + v[j][1] + v[j][2] + v[j][3];
        const float mu = wave_sum(s) * (1.f / 1024.f);
        float q = 0.f;
#pragma unroll
        for (int j = 0; j < 4; ++j)
#pragma unroll
            for (int i = 0; i < 4; ++i) { const float d = v[j][i] - mu; q += d * d; }
        const float rstd = rsqrtf(wave_sum(q) * (1.f / 1024.f) + 1e-5f);
#pragma unroll
        for (int j = 0; j < 4; ++j) {
#pragma unroll
            for (int i = 0; i < 4; ++i) v[j][i] = (v[j][i] - mu) * rstd * gv[j][i] + bv[j][i];
            *(f32x4*)(row + j * 256 + lane * 4) = v[j];
            if (write_xb) { u32x2 w = {cvtpk(v[j][0], v[j][1]), cvtpk(v[j][2], v[j][3])}; *(u32x2*)(xb + (size_t)t * 1024 + j * 256 + lane * 4) = w; }
        }
    };
    auto loadrow = [&](f32x4 (&d)[4], int& sl, f32x2& stt, int t) {
        const float* r = outp + (size_t)t * 1024 + lane * 4;
#pragma unroll
        for (int j = 0; j < 4; ++j) d[j] = *(const f32x4*)(r + j * 256);
        sl = slot[(size_t)t * 16 + (lane & 15)]; stt = stats[t];
    };
    const int st = gridDim.x * 8, t0 = blockIdx.x * 8 + wid;
    f32x4 A_[4], B_[4], v[4]; int sA = -1, sB = -1; f32x2 tA = {0.f, 0.f}, tB = {0.f, 0.f};
    loadrow(A_, sA, tA, t0); if (t0 + st < T_TOK) loadrow(B_, sB, tB, t0 + st);
    for (int t = t0; t < T_TOK; t += 2 * st) {
        { const int sl = sA; const f32x2 stt = tA;
#pragma unroll
          for (int j = 0; j < 4; ++j) v[j] = A_[j];
          if (t + 2 * st < T_TOK) loadrow(A_, sA, tA, t + 2 * st);
          process(v, sl, stt, t); }
        if (t + st < T_TOK) {
            const int sl = sB; const f32x2 stt = tB;
#pragma unroll
            for (int j = 0; j < 4; ++j) v[j] = B_[j];
            if (t + 3 * st < T_TOK) loadrow(B_, sB, tB, t + 3 * st);
            process(v, sl, stt, t + st);
        }
    }
}

__device__ __forceinline__ void phase_mlaprep(const Params& p) {
    const int tid_ = otid(); const int wid = __builtin_amdgcn_readfirstlane(tid_ >> 6), lane = tid_ & 63;
    const float* raw = (const float*)(p.ws + WS_RAWDN);
    bf16_t* cqn = (bf16_t*)(p.ws + WS_CQN); bf16_t* ckvn = (bf16_t*)(p.ws + WS_CKVN); bf16_t* kr = (bf16_t*)(p.ws + WS_KR);
    const float* mc = (const float*)(p.ws + TAB_MLA_C); const float* ms = (const float*)(p.ws + TAB_MLA_S);
    const f32x4 qn = *(const f32x4*)(p.in[7] + lane * 4); const f32x2 kn = *(const f32x2*)(p.in[8] + lane * 2);
    for (int t = blockIdx.x * 8 + wid; t < T_TOK; t += gridDim.x * 8) {
        const float* r = raw + (size_t)t * 512;
        const f32x4 cq = *(const f32x4*)(r + lane * 4); const f32x2 ck = *(const f32x2*)(r + 256 + lane * 2);
        const float rq = rsqrtf(wave_sum(cq[0] * cq[0] + cq[1] * cq[1] + cq[2] * cq[2] + cq[3] * cq[3]) * (1.f / 256.f) + 1e-6f);
        const float rk = rsqrtf(wave_sum(ck[0] * ck[0] + ck[1] * ck[1]) * (1.f / 128.f) + 1e-6f);
        u32x2 wq = {cvtpk(cq[0] * rq * qn[0], cq[1] * rq * qn[1]), cvtpk(cq[2] * rq * qn[2], cq[3] * rq * qn[3])};
        *(u32x2*)(cqn + (size_t)t * 256 + lane * 4) = wq;
        *(unsigned*)(ckvn + (size_t)t * 128 + lane * 2) = cvtpk(ck[0] * rk * kn[0], ck[1] * rk * kn[1]);
        if (lane < 16) { const int s = t & (SEQ - 1); const float x1 = r[384 + lane], x2 = r[400 + lane]; const float c = mc[s * 16 + lane], sn = ms[s * 16 + lane];
            *(unsigned*)(kr + (size_t)t * 32 + 2 * lane) = cvtpk(x1 * c - x2 * sn, x2 * c + x1 * sn); }
    }
}

#define XB_TMO      128
#define XB_XCNT(j)  (256  + 64 * (j))
#define XB_XSUB(j)  (1280 + 64 * (j))
#define XB_XGEN(j)  (2304 + 64 * (j))
#define XB_TOP      3328
#define XB_TOPGEN   3392
#define XCD_BAR_WORDS 3456
#define XB_SPIN_CAP (1u << 20)
__device__ __forceinline__ unsigned xb_ld(unsigned* p)              { return __hip_atomic_load(p, __ATOMIC_RELAXED, __HIP_MEMORY_SCOPE_AGENT); }
__device__ __forceinline__ unsigned xb_add(unsigned* p, unsigned v) { return __hip_atomic_fetch_add(p, v, __ATOMIC_RELAXED, __HIP_MEMORY_SCOPE_AGENT); }
__device__ __forceinline__ unsigned xb_xcc_id() { return (unsigned)__builtin_amdgcn_s_getreg((3 << 11) | 20) & 0xFu; }
#define XB_SPIN(cond, bar) do { unsigned _sp = 0; while (cond) { __builtin_amdgcn_s_sleep(1); \
    if ((++_sp & 255u) == 0u) { if (xb_ld(&(bar)[XB_TMO])) break; if (_sp > XB_SPIN_CAP) { atomicAdd(&(bar)[XB_TMO], 1u); break; } } } } while (0)
struct XcdBarrier { unsigned* bar; unsigned x; volatile LAS unsigned* st; };
__device__ __forceinline__ XcdBarrier xcd_barrier_post(unsigned* bar, volatile LAS unsigned* st) {
    XcdBarrier b; b.bar = bar; b.x = xb_xcc_id(); b.st = st;
    if (threadIdx.x == 0) (void)xb_add(&bar[XB_XCNT(b.x)], 1u);
    return b;
}
__device__ __forceinline__ void xcd_barrier_complete(unsigned* bar, unsigned x, unsigned& nloc, unsigned& nx) {
    const unsigned G = gridDim.x * gridDim.y * gridDim.z;
    unsigned sum, cnt, mine, sp = 0u;
    for (;;) {
        sum = 0u; cnt = 0u; mine = 0u;
#pragma unroll
        for (unsigned j = 0; j < 16; ++j) { const unsigned c = xb_ld(&bar[XB_XCNT(j)]); sum += c; cnt += (c > 0u) ? 1u : 0u; mine = (j == x) ? c : mine; }
        if (sum == G) break;
        __builtin_amdgcn_s_sleep(1);
        if ((++sp & 255u) == 0u) { if (xb_ld(&bar[XB_TMO])) break; if (sp > XB_SPIN_CAP) { atomicAdd(&bar[XB_TMO], 1u); break; } }
    }
    nloc = mine > 0u ? mine : 1u; nx = cnt > 0u ? cnt : 1u;
}
__device__ __forceinline__ void xcd_barrier(const XcdBarrier& b) {
    asm volatile("s_waitcnt vmcnt(0)" ::: "memory");
    __syncthreads();
    if (threadIdx.x == 0) {
        unsigned* bar = b.bar;
        __builtin_amdgcn_s_waitcnt(0);
        unsigned nloc = b.st[0], nx = b.st[1];
        if (nloc == 0u) { xcd_barrier_complete(bar, b.x, nloc, nx); b.st[0] = nloc; b.st[1] = nx; }
        const unsigned old = xb_add(&bar[XB_XSUB(b.x)], 1u);
        const unsigned gen = old / nloc;
        if (old + 1u == (gen + 1u) * nloc) {
            __builtin_amdgcn_fence(__ATOMIC_RELEASE, "agent");
            asm volatile("s_waitcnt vmcnt(0)" ::: "memory");
            const unsigned og = xb_add(&bar[XB_TOP], 1u);
            const unsigned tg = og / nx;
            if (og + 1u == (tg + 1u) * nx) xb_add(&bar[XB_TOPGEN], 1u);
            else XB_SPIN(xb_ld(&bar[XB_TOPGEN]) == tg, bar);
            __builtin_amdgcn_fence(__ATOMIC_ACQUIRE, "agent");
            xb_add(&bar[XB_XGEN(b.x)], 1u);
            asm volatile("s_waitcnt vmcnt(0)" ::: "memory");
        } else {
            XB_SPIN(xb_ld(&bar[XB_XGEN(b.x)]) == gen, bar);
            __builtin_amdgcn_fence(__ATOMIC_ACQUIRE, "agent");
            asm volatile("s_waitcnt vmcnt(0)" ::: "memory");
        }
    }
    __syncthreads();
}

__global__ void __launch_bounds__(512, 2) mega(Params p) {
    extern __shared__ __attribute__((aligned(16))) unsigned char shm[];
    cg::grid_group grid = cg::this_grid();
    LAS unsigned char* lds3 = (LAS unsigned char*)shm;
    unsigned char* ws = p.ws;
    const int G = gridDim.x, c = blockIdx.x;
    int ph = 0;
    volatile LAS unsigned* xst = (volatile LAS unsigned*)(lds3 + 131072);
    if (threadIdx.x == 0) { xst[0] = 0u; xst[1] = 0u; }
    __syncthreads();
    XcdBarrier xbar = xcd_barrier_post((unsigned*)(ws + WS_BAR), xst);
#ifndef SITE_MASK
#define SITE_MASK 0xffff
#endif
#ifndef DUP_MASK
#define DUP_MASK 0
#endif
#define PHASE_BEGIN(site) if (((SITE_MASK >> (site)) & 1) && ph >= p.ph_lo && ph < p.ph_hi) for (int rep_ = 0; rep_ < 1 + ((DUP_MASK >> (site)) & 1); ++rep_) {
#define PHASE_END } ++ph; if (ph > p.ph_lo && ph < p.ph_hi) { if (ph == 1) grid.sync(); else xcd_barrier(xbar); }
    PHASE_BEGIN(0) phase_convert(p, shm); PHASE_END
#ifdef EXTRA_SYNCS
    for (int i_ = 0; i_ < EXTRA_SYNCS; ++i_) xcd_barrier(xbar);
#endif
    const float* tsc = (const float*)(ws + TAB_SEQ_C); const float* tss = (const float*)(ws + TAB_SEQ_S);
    const float* tmc = (const float*)(ws + TAB_MLA_C); const float* tms = (const float*)(ws + TAB_MLA_S);
    const float* trc = (const float*)(ws + TAB_ROW_C); const float* trs = (const float*)(ws + TAB_ROW_S);
    const float* tcc = (const float*)(ws + TAB_COL_C); const float* tcs = (const float*)(ws + TAB_COL_S);
    const bf16_t* xb = (const bf16_t*)(ws + WS_XB);
    PHASE_BEGIN(1) { Sched S{256, 6, 1536, G, c, 0}; EpiQKV0 E{(bf16_t*)(ws + WS_PROJ), p.in[2], p.in[3], trc, trs, tcc, tcs, tsc, tss};
        gemm_phase(lds3, xb, (const bf16_t*)(ws + W_IN0), 1024, S, E); } PHASE_END
    PHASE_BEGIN(2) phase_attn0(p, (char*)shm); PHASE_END
    PHASE_BEGIN(3) { Sched S{256, 4, 1024, G, c, 0}; EpiRes E{p.in[0], p.out};
        gemm_phase(lds3, (const bf16_t*)(ws + WS_ATT0), (const bf16_t*)(ws + W_OUT0), 1024, S, E); } PHASE_END
    for (int layer = 0; layer < 2; ++layer) {
        if (layer == 1) {
            PHASE_BEGIN(4) { Sched S{256, 2, 512, G, c, 0}; EpiF32 E{(float*)(ws + WS_RAWDN), 512};
                gemm_phase(lds3, xb, (const bf16_t*)(ws + W_DN1), 1024, S, E); } PHASE_END
            PHASE_BEGIN(5) phase_mlaprep(p); PHASE_END
            PHASE_BEGIN(6) { Sched S{256, 6, 1536, G, c, 0}; EpiBf16<2> E{(bf16_t*)(ws + WS_Q), 1536, nullptr, tmc, tms};
                    gemm_phase(lds3, (const bf16_t*)(ws + WS_CQN), (const bf16_t*)(ws + W_UQ), 256, S, E); } PHASE_END
            PHASE_BEGIN(15) { Sched S{256, 8, 2048, G, c, 0}; EpiBf16<0> E{(bf16_t*)(ws + WS_KV), 2048, nullptr, nullptr, nullptr};
                    gemm_phase(lds3, (const bf16_t*)(ws + WS_CKVN), (const bf16_t*)(ws + W_UKV), 128, S, E); } PHASE_END
            PHASE_BEGIN(7) phase_attn1(p, (char*)shm); PHASE_END
            PHASE_BEGIN(8) { Sched S{256, 4, 1024, G, c, 0}; EpiRes E{p.out, p.out};
                gemm_phase(lds3, (const bf16_t*)(ws + WS_ATT1), (const bf16_t*)(ws + W_OUT1), 1024, S, E); } PHASE_END
        }
        PHASE_BEGIN(9) phase_ln1(p, layer, shm); PHASE_END
        PHASE_BEGIN(10) phase_topk(p, shm); PHASE_END
        PHASE_BEGIN(12) { Sched S{4, 8, 4096, G, c, 1}; EpiSwiGLU E{(bf16_t*)(ws + WS_H)};
            gemm_phase<EpiSwiGLU, true>(lds3, xb, (const bf16_t*)(ws + (layer ? W_GU1 : W_GU0)), 1024, S, E, (const int*)(ws + WS_IDX)); } PHASE_END
        PHASE_BEGIN(13) { Sched S{4, 4, 2048, G, c, 1}; EpiBf16<1> E{(bf16_t*)(ws + WS_Y), 1024, (const float*)(ws + WS_GATE), nullptr, nullptr};
            gemm_phase(lds3, (const bf16_t*)(ws + WS_H), (const bf16_t*)(ws + (layer ? W_D1 : W_D0)), 1024, S, E); } PHASE_END
        PHASE_BEGIN(14) phase_ln2(p, layer, layer == 0); PHASE_END
    }
}

extern "C" void kernel_launch(void* const* d_in, const int* in_sizes, int n_in, void* d_out, int out_size, void* d_ws, size_t ws_size, hipStream_t stream) {
    static int grid = 0;
    if (grid == 0) {
        if (n_in != 20 || out_size != T_TOK * DM || ws_size < WS_END) { fprintf(stderr, "kernel_launch: unexpected shapes n_in %d out %d ws %zu (need %zu)\n", n_in, out_size, ws_size, (size_t)WS_END); grid = -1; return; }
        int dev = 0, cus = 0, per_cu = 0;
        hipGetDevice(&dev); hipDeviceGetAttribute(&cus, hipDeviceAttributeMultiprocessorCount, dev);
        if (hipFuncSetAttribute((const void*)mega, hipFuncAttributeMaxDynamicSharedMemorySize, LDS_BYTES) != hipSuccess) { fprintf(stderr, "kernel_launch: hipFuncSetAttribute failed\n"); grid = -1; return; }
        if (hipOccupancyMaxActiveBlocksPerMultiprocessor(&per_cu, (const void*)mega, 512, LDS_BYTES) != hipSuccess || per_cu < 1) { fprintf(stderr, "kernel_launch: occupancy query %d\n", per_cu); per_cu = 1; }
        (void)hipGetLastError();
        grid = cus * 1;
    }
    if (grid < 0) return;
    Params p{};
    for (int i = 0; i < 20; ++i) p.in[i] = (const float*)d_in[i];
    p.out = (float*)d_out; p.ws = (unsigned char*)d_ws; p.ph_lo = 0; p.ph_hi = 1000;
    if (hipMemsetAsync((char*)d_ws + WS_BAR, 0, XCD_BAR_WORDS * 4, stream) != hipSuccess) { fprintf(stderr, "kernel_launch: memset failed\n"); return; }
    void* args[] = {&p};
    hipError_t e = hipLaunchCooperativeKernel((const void*)mega, dim3(grid), dim3(512), args, LDS_BYTES, stream);
    if (e != hipSuccess) fprintf(stderr, "kernel_launch: cooperative launch failed: %s (grid %d)\n", hipGetErrorString(e), grid);
}
```

```cpp
#include <hip/hip_runtime.h>
#include <hip/hip_cooperative_groups.h>
#include <cstdio>
#include <cstdint>
namespace cg = cooperative_groups;

#define LAS __attribute__((address_space(3)))
typedef unsigned short bf16_t;
typedef short bf16x8 __attribute__((ext_vector_type(8)));
typedef short s16x4 __attribute__((ext_vector_type(4)));
typedef float f32x4 __attribute__((ext_vector_type(4)));
typedef float f32x2 __attribute__((ext_vector_type(2)));
typedef float f32x16 __attribute__((ext_vector_type(16)));
typedef unsigned u32x4 __attribute__((ext_vector_type(4)));
typedef unsigned u32x2 __attribute__((ext_vector_type(2)));

constexpr int T_TOK = 65536, DM = 1024, SEQ = 8192;
constexpr float ALPHA = 1.4142135623730951f;
constexpr int LDS_BYTES = 131072 + 64;

constexpr size_t MiB = 1048576;
constexpr size_t W_IN0 = 0, W_OUT0 = 3 * MiB, W_GU0 = 5 * MiB, W_D0 = 69 * MiB, W_DN1 = 101 * MiB, W_UQ = 102 * MiB, W_UKV = 103 * MiB,
                 W_OUT1 = 104 * MiB, W_GU1 = 106 * MiB, W_D1 = 170 * MiB;
constexpr size_t WS_TAB = 202 * MiB;
constexpr size_t TAB_SEQ_C = WS_TAB, TAB_SEQ_S = WS_TAB + 1 * MiB, TAB_MLA_C = WS_TAB + 2 * MiB, TAB_MLA_S = WS_TAB + 2 * MiB + 512 * 1024,
                 TAB_ROW_C = WS_TAB + 3 * MiB, TAB_ROW_S = TAB_ROW_C + 8192, TAB_COL_C = TAB_ROW_S + 8192, TAB_COL_S = TAB_COL_C + 4096;
constexpr size_t WS_BAR = WS_TAB + 3 * MiB + 65536;
constexpr size_t WS_STATS = WS_TAB + 3 * MiB + 131072;
constexpr size_t WS_AFF = 206 * MiB, WS_IDX = 210 * MiB, WS_GATE = 210 * MiB + 512 * 1024, WS_SLOT = 211 * MiB;
constexpr size_t WS_XB = 216 * MiB;
constexpr size_t WS_CQN = WS_XB, WS_CKVN = WS_XB + 32 * MiB, WS_KR = WS_XB + 48 * MiB;
constexpr size_t WS_R = 344 * MiB;
constexpr size_t WS_PROJ = WS_R, WS_ATT0 = WS_R + 192 * MiB;
constexpr size_t WS_Q = WS_R, WS_KV = WS_R + 192 * MiB, WS_ATT1 = WS_R + 448 * MiB, WS_RAWDN = WS_R + 448 * MiB;
constexpr size_t WS_XG = WS_R, WS_H = WS_R + 256 * MiB, WS_Y = WS_R;
constexpr size_t WS_END = WS_R + 576 * MiB;

struct Params {
    const float* in[20];
    float* out;
    unsigned char* ws;
    int ph_lo, ph_hi;
};

__device__ __forceinline__ unsigned cvtpk(float lo, float hi) { unsigned r; asm volatile("v_cvt_pk_bf16_f32 %0, %1, %2" : "=v"(r) : "v"(lo), "v"(hi)); return r; }
__device__ __forceinline__ int otid() { int t = threadIdx.x; asm volatile("" : "+v"(t)); return t; }
__device__ __forceinline__ float bf2f(unsigned short b) { return __uint_as_float(((unsigned)b) << 16); }
__device__ __forceinline__ float dpp_f(float v, const int ctrl_sel) {
    const int iv = __builtin_bit_cast(int, v); int r;
    switch (ctrl_sel) { case 1: r = __builtin_amdgcn_update_dpp(0, iv, 0x111, 0xf, 0xf, true); break; case 2: r = __builtin_amdgcn_update_dpp(0, iv, 0x112, 0xf, 0xf, true); break;
                        case 4: r = __builtin_amdgcn_update_dpp(0, iv, 0x114, 0xf, 0xf, true); break; case 8: r = __builtin_amdgcn_update_dpp(0, iv, 0x118, 0xf, 0xf, true); break;
                        case 15: r = __builtin_amdgcn_update_dpp(0, iv, 0x142, 0xa, 0xf, false); break; default: r = __builtin_amdgcn_update_dpp(0, iv, 0x143, 0xc, 0xf, false); break; }
    return __builtin_bit_cast(float, r);
}
__device__ __forceinline__ float wave_sum(float v) {
    v += dpp_f(v, 1); v += dpp_f(v, 2); v += dpp_f(v, 4); v += dpp_f(v, 8); v += dpp_f(v, 15); v += dpp_f(v, 31);
    return __builtin_bit_cast(float, __builtin_amdgcn_readlane(__builtin_bit_cast(int, v), 63));
}

enum { MAP_NAT = 0, MAP_P32 = 1, MAP_GU = 2, MAP_QKV0 = 3, MAP_UQ = 4, MAP_DN1 = 5 };
__device__ __forceinline__ int map_src(int mode, int ns, int& which) {
    which = 0;
    const int t = ns >> 8, s = ns & 255, bj = s >> 7, wc = (s >> 5) & 3, rho = s & 31;
    const int q32 = ((rho >> 2) & 3) * 8 + (rho >> 4) * 4 + (rho & 3);
    if (mode == MAP_NAT) return ns;
    if (mode == MAP_DN1) return ns < 416 ? ns : -1;
    if (mode == MAP_P32) return (ns & ~31) + q32;
    if (mode == MAP_GU) { which = bj; return t * 128 + wc * 32 + q32; }
    if (mode == MAP_QKV0) {
        const int head = 4 * t + wc, pp = 32 * bj + q32;
        int orig;
        if (head < 10) { const int blk = pp >> 5, q = pp & 31; orig = blk * 32 + (q & 1) * 16 + (q >> 1); }
        else if (head >= 12 && head < 22) { orig = (pp & 1) * 32 + (pp >> 1); }
        else orig = pp;
        return head * 64 + orig;
    }
    const int c = (ns & ~31) + q32; const int g = c >> 5, head = g / 3, part = g - head * 3;
    const int orig = part < 2 ? part * 32 + q32 : 64 + (q32 & 1) * 16 + (q32 >> 1);
    return head * 96 + orig;
}

__device__ __forceinline__ void cvt_tile(const float* s0, const float* s1, int ld, int mode, bf16_t* dst, int K, int n0, int k0, float* tl) {
    const int tid = otid();
    const int nl = tid & 63, kb = tid >> 6;
    int which; const int sc = map_src(mode, n0 + nl, which);
    const float* src = which ? s1 : s0;
    float ld_[16];
#pragma unroll
    for (int i = 0; i < 16; ++i) { const int k = i * 8 + kb; ld_[i] = sc >= 0 ? src[(size_t)(k0 + k) * ld + sc] : 0.f; }
#pragma unroll
    for (int i = 0; i < 16; ++i) { const int k = i * 8 + kb; tl[k * 65 + nl] = ld_[i]; }
    __syncthreads();
    const int nr = tid >> 3, kc = (tid & 7) * 8;
#pragma unroll
    for (int h = 0; h < 2; ++h) {
        float v[8];
#pragma unroll
        for (int j = 0; j < 8; ++j) v[j] = tl[(h * 64 + kc + j) * 65 + nr];
        u32x4 w = {cvtpk(v[0], v[1]), cvtpk(v[2], v[3]), cvtpk(v[4], v[5]), cvtpk(v[6], v[7])};
        *(u32x4*)(dst + (size_t)(n0 + nr) * K + k0 + h * 64 + kc) = w;
    }
    __syncthreads();
}

__device__ __forceinline__ void cvt_tile_w(const float* s0, const float* s1, int ld, int mode, bf16_t* dst, int K, int n0, int k0, float* tl) {
    const int tid = otid();
    const int n4 = tid & 15, kb = tid >> 4;
    int which; const int sc = map_src(mode, n0 + 4 * n4, which);
    const float* src = (which ? s1 : s0) + sc;
    f32x4 ld_[8];
#pragma unroll
    for (int i = 0; i < 8; ++i) ld_[i] = *(const f32x4*)(src + (size_t)(k0 + i * 32 + kb) * ld);
#pragma unroll
    for (int i = 0; i < 8; ++i) { float* t = tl + (i * 32 + kb) * 65 + 4 * n4; t[0] = ld_[i][0]; t[1] = ld_[i][1]; t[2] = ld_[i][2]; t[3] = ld_[i][3]; }
    __syncthreads();
    const int nr = tid >> 3, kc = (tid & 7) * 8;
#pragma unroll
    for (int h = 0; h < 4; ++h) {
        float v[8];
#pragma unroll
        for (int j = 0; j < 8; ++j) v[j] = tl[(h * 64 + kc + j) * 65 + nr];
        u32x4 w = {cvtpk(v[0], v[1]), cvtpk(v[2], v[3]), cvtpk(v[4], v[5]), cvtpk(v[6], v[7])};
        *(u32x4*)(dst + (size_t)(n0 + nr) * K + k0 + h * 64 + kc) = w;
    }
    __syncthreads();
}

__device__ __forceinline__ void cvt_job(const float* s0, const float* s1, size_t estride, int nexp, int ld, int mode, int K, int N, bf16_t* dst, int& tbase, float* tl) {
    if ((mode == MAP_NAT || mode == MAP_P32 || mode == MAP_GU) && (K & 255) == 0) {
        const int kt_n = K >> 8, tpe = (N >> 6) * kt_n, nt = nexp * tpe, G = gridDim.x;
        const int first = ((int)blockIdx.x - (tbase % G) + G) % G;
        for (int t = first; t < nt; t += G) {
            const int e = t / tpe, r = t - e * tpe, ntile = r / kt_n, kt = r - ntile * kt_n;
            cvt_tile_w(s0 + (size_t)e * estride, s1 + (size_t)e * estride, ld, mode, dst + (size_t)e * N * K, K, ntile * 64, kt * 256, tl);
        }
        tbase += nt;
        return;
    }
    const int kt_n = K >> 7, tpe = (N >> 6) * kt_n, nt = nexp * tpe, G = gridDim.x;
    const int first = ((int)blockIdx.x - (tbase % G) + G) % G;
    for (int t = first; t < nt; t += G) {
        const int e = t / tpe, r = t - e * tpe, ntile = r / kt_n, kt = r - ntile * kt_n;
        cvt_tile(s0 + (size_t)e * estride, s1 + (size_t)e * estride, ld, mode, dst + (size_t)e * N * K, K, ntile * 64, kt * 128, tl);
    }
    tbase += nt;
}

__device__ __forceinline__ void sincos_acc(float ang, float& c, float& s) {
    const double a = (double)ang; const double n = rint(a * 0.15915494309189535);
    double r = fma(-n, 6.283185307179586, a); r = fma(-n, 2.4492935982947064e-16, r);
    const float rf = (float)r; c = cosf(rf); s = sinf(rf);
}
__device__ __forceinline__ float rope_freq(int i, int dim) { return (float)exp2(-((double)(2 * i) / (double)dim) * 13.287712379549449); }

__device__ __forceinline__ void phase_convert(const Params& p, unsigned char* lds) {
    float* tl = (float*)lds;
    unsigned char* ws = p.ws;
    int tb = 0;
    const size_t EW = (size_t)1024 * 1024;
#pragma unroll 1
    for (int j = 0; j < 10; ++j) {
        const float *s0, *s1; size_t es = 0, dsto; int nexp = 1, ld, mode, K, N;
        switch (j) {
            case 0: s0 = s1 = p.in[1]; ld = 1536; mode = MAP_QKV0; K = 1024; N = 1536; dsto = W_IN0; break;
            case 1: s0 = s1 = p.in[5]; ld = 1024; mode = MAP_NAT; K = 1024; N = 1024; dsto = W_OUT0; break;
            case 2: s0 = p.in[15]; s1 = p.in[16]; es = EW; nexp = 16; ld = 1024; mode = MAP_GU; K = 1024; N = 2048; dsto = W_GU0; break;
            case 3: s0 = s1 = p.in[17]; es = EW; nexp = 16; ld = 1024; mode = MAP_P32; K = 1024; N = 1024; dsto = W_D0; break;
            case 4: s0 = s1 = p.in[6]; ld = 416; mode = MAP_DN1; K = 1024; N = 512; dsto = W_DN1; break;
            case 5: s0 = s1 = p.in[9]; ld = 1536; mode = MAP_UQ; K = 256; N = 1536; dsto = W_UQ; break;
            case 6: s0 = s1 = p.in[10]; ld = 2048; mode = MAP_P32; K = 128; N = 2048; dsto = W_UKV; break;
            case 7: s0 = s1 = p.in[11]; ld = 1024; mode = MAP_NAT; K = 1024; N = 1024; dsto = W_OUT1; break;
            case 8: s0 = p.in[15] + 16 * EW; s1 = p.in[16] + 16 * EW; es = EW; nexp = 16; ld = 1024; mode = MAP_GU; K = 1024; N = 2048; dsto = W_GU1; break;
            default: s0 = s1 = p.in[17] + 16 * EW; es = EW; nexp = 16; ld = 1024; mode = MAP_P32; K = 1024; N = 1024; dsto = W_D1; break;
        }
        cvt_job(s0, s1, es, nexp, ld, mode, K, N, (bf16_t*)(ws + dsto), tb, tl);
    }
    {
        const float* x = p.in[0]; bf16_t* xb = (bf16_t*)(ws + WS_XB);
        const size_t n8 = (size_t)T_TOK * DM / 8;
        for (size_t i = (size_t)blockIdx.x * 512 + otid(); i < n8; i += (size_t)gridDim.x * 512) {
            const f32x4 a = *(const f32x4*)(x + i * 8), b = *(const f32x4*)(x + i * 8 + 4);
            u32x4 w = {cvtpk(a[0], a[1]), cvtpk(a[2], a[3]), cvtpk(b[0], b[1]), cvtpk(b[2], b[3])};
            *(u32x4*)(xb + i * 8) = w;
        }
    }
    {
        float* sc_ = (float*)(ws + TAB_SEQ_C); float* ss_ = (float*)(ws + TAB_SEQ_S);
        float* mc_ = (float*)(ws + TAB_MLA_C); float* ms_ = (float*)(ws + TAB_MLA_S);
        float* rc_ = (float*)(ws + TAB_ROW_C); float* rs_ = (float*)(ws + TAB_ROW_S);
        float* cc_ = (float*)(ws + TAB_COL_C); float* cs_ = (float*)(ws + TAB_COL_S);
        const int n1 = SEQ * 32, n2 = SEQ * 16, n3 = 128 * 16, n4 = 64 * 16, ntot = n1 + n2 + n3 + n4;
        for (int i = blockIdx.x * 512 + otid(); i < ntot; i += gridDim.x * 512) {
            float c, s;
            if (i < n1) { const int pos = i >> 5, f = i & 31; sincos_acc((float)pos * rope_freq(f, 64), c, s); sc_[i] = c; ss_[i] = s; }
            else if (i < n1 + n2) { const int j = i - n1, pos = j >> 4, f = j & 15; sincos_acc((float)pos * rope_freq(f, 32), c, s); mc_[j] = c; ms_[j] = s; }
            else if (i < n1 + n2 + n3) { const int j = i - n1 - n2, pos = j >> 4, f = j & 15; sincos_acc((float)pos * rope_freq(f, 32), c, s); rc_[j] = c; rs_[j] = s; }
            else { const int j = i - n1 - n2 - n3, pos = j >> 4, f = j & 15; sincos_acc((float)pos * rope_freq(f, 32), c, s); cc_[j] = c; cs_[j] = s; }
        }
    }
}

constexpr int BM = 256, BK = 64, HALF = 128, HTB = HALF * BK * 2, STAGE_BYTES = 8 * HTB;
__device__ __forceinline__ int lds_byte(int r, int c) { const int st = (r >> 4) * 2 + (c >> 5), rr = r & 15, cc = c & 31, ob = rr * 64 + cc * 2; return st * 1024 + (ob ^ (((ob >> 9) & 1) << 5)); }
__device__ __forceinline__ void stage_rc(int b, int& R, int& C) { const int st = b / 1024, sb = b % 1024, swz = sb ^ (((sb >> 9) & 1) << 5); R = (st >> 1) * 16 + swz / 64; C = (st & 1) * 32 + (swz % 64) / 2; }

struct Unit { int arow, brow, orow, pn; };
struct Sched {
    int nM, nN, total, G, c, moe;
    __device__ __forceinline__ bool next(int i, Unit& u) const {
        const int L = i * G + c; if (L >= total) return false;
        if (!moe) {
            int wgid = L; { const int q = total / 8, r = total % 8, xcd = wgid % 8, off = wgid / 8; wgid = (xcd < r ? xcd * (q + 1) : r * (q + 1) + (xcd - r) * q) + off; }
            const int nig = 8 * nN, gid = wgid / nig, fm = gid * 8, gsz = (nM - fm) < 8 ? (nM - fm) : 8;
            const int pm = fm + ((wgid % nig) % gsz), pn = (wgid % nig) / gsz;
            u.arow = pm * 256; u.brow = pn * 256; u.orow = u.arow; u.pn = pn; return true;
        }
        const int upg = nM * nN; const int g = L / upg, r = L - g * upg; const int pn = r / nM, pm = r - pn * nM;
        const int e = g >> 3, b = g & 7; const int ga = b * 16 + e, gb = e;
        u.arow = (ga * nM + pm) * 256; u.brow = (gb * nN + pn) * 256; u.orow = u.arow; u.pn = pn; return true;
    }
};

template <class Epi, bool GATHER = false>
__device__ __forceinline__ void gemm_phase(LAS unsigned char* lds, const bf16_t* A, const bf16_t* Bt, const int K_, const Sched& S, const Epi& E, const int* gidx = nullptr) {
    int K = K_; asm volatile("" : "+s"(K));
    const int tid = otid(), wid = __builtin_amdgcn_readfirstlane(tid >> 6), lane = tid & 63, wr = wid >> 2, wc = wid & 3, fr = lane & 15, fq = lane >> 4;
    const int nt = K / BK;
    unsigned voffA[2]; int Rv[2], Cb[2];
#pragma unroll
    for (int i = 0; i < 2; ++i) { int R, C; stage_rc(tid * 16 + i * 8192, R, C); voffA[i] = (unsigned)(R * K + C) * 2u; Rv[i] = R; Cb[i] = C * 2; }
    unsigned coff[2][2], noff[2][2];
    auto load_off = [&](int arow, unsigned (&o)[2][2]) {
#pragma unroll
        for (int h = 0; h < 2; ++h)
#pragma unroll
            for (int i = 0; i < 2; ++i) { const int r = arow + h * 128 + Rv[i]; const int tok = (r >> 14) * SEQ + gidx[r]; o[h][i] = (unsigned)tok * (unsigned)(K * 2) + (unsigned)Cb[i]; }
    };
    const size_t kstep = (size_t)(BK * 2);
    const size_t hstep = (size_t)HALF * K * 2;
    const size_t rstep = (size_t)K * 2;
    const unsigned ldsw = (unsigned)wid * 1024u;
    const int aoff = lds_byte(wr * 64 + fr, fq * 8), boff = lds_byte(wc * 32 + fr, fq * 8);
#define PG8_SA(b, h) (((b) * 2 + (h)) * HTB)
#define PG8_SB(b, h) ((4 + (b) * 2 + (h)) * HTB)
#define PG8_STAGE(bufoff, gbase, voff) do { _Pragma("unroll") for (int _i = 0; _i < 2; ++_i) \
        __builtin_amdgcn_global_load_lds((const unsigned*)((const char*)(gbase) + (voff)[_i]), (LAS unsigned*)(lds + (bufoff) + ldsw + _i * 8192), 16, 0, 0); } while (0)
#define STG_A(bufoff, kb, h, usen) do { if constexpr (GATHER) { unsigned o_[2] = {(usen) ? noff[h][0] : coff[h][0], (usen) ? noff[h][1] : coff[h][1]}; PG8_STAGE(bufoff, (const char*)A + (kb), o_); } \
        else { PG8_STAGE(bufoff, ((usen) ? nA : cA) + (kb) + (size_t)(h) * hstep, voffA); } } while (0)
#define PG8_LDA(dst, b, h) do { _Pragma("unroll") for (int m = 0; m < 4; ++m) _Pragma("unroll") for (int k = 0; k < 2; ++k) dst[m][k] = *(const LAS bf16x8*)(lds + PG8_SA(b, h) + aoff + m * 2048 + k * 1024); } while (0)
#define PG8_LDB(dst, b, h) do { _Pragma("unroll") for (int n = 0; n < 2; ++n) _Pragma("unroll") for (int k = 0; k < 2; ++k) dst[n][k] = *(const LAS bf16x8*)(lds + PG8_SB(b, h) + boff + n * 2048 + k * 1024); } while (0)
#define PG8_MMA(ai, bj, At, Bt_) do { __builtin_amdgcn_s_setprio(1); _Pragma("unroll") for (int m = 0; m < 4; ++m) _Pragma("unroll") for (int n = 0; n < 2; ++n) _Pragma("unroll") for (int k = 0; k < 2; ++k) \
        acc[ai][bj][m][n] = __builtin_amdgcn_mfma_f32_16x16x32_bf16(Bt_[n][k], At[m][k], acc[ai][bj][m][n], 0, 0, 0); __builtin_amdgcn_s_setprio(0); } while (0)
#define PG8_WAIT_V(n) asm volatile("s_waitcnt vmcnt(" #n ")" ::: "memory")
#define PG8_WAIT_L(n) asm volatile("s_waitcnt lgkmcnt(" #n ")" ::: "memory")
#define PG8_BAR __builtin_amdgcn_s_barrier()
#define PG8_SCHED __builtin_amdgcn_sched_barrier(0)
    Unit cur, nxt; int ui = 0;
    if (!S.next(0, cur)) return;
    f32x4 acc[2][2][4][2];
#pragma unroll
    for (int a = 0; a < 2; ++a)
#pragma unroll
        for (int b = 0; b < 2; ++b)
#pragma unroll
            for (int m = 0; m < 4; ++m)
#pragma unroll
                for (int n = 0; n < 2; ++n) acc[a][b][m][n] = (f32x4){0.f, 0.f, 0.f, 0.f};
    bf16x8 At[4][2], B0[2][2], B1[2][2];
    const char* cA = (const char*)A + (size_t)cur.arow * rstep; const char* cB = (const char*)Bt + (size_t)cur.brow * rstep;
    const char* nA = cA;
    if constexpr (GATHER) { load_off(cur.arow, coff); }
    PG8_STAGE(PG8_SB(0, 0), cB, voffA); STG_A(PG8_SA(0, 0), (size_t)0, 0, false); PG8_STAGE(PG8_SB(0, 1), cB + hstep, voffA); STG_A(PG8_SA(0, 1), (size_t)0, 1, false);
    if (wr == 1) PG8_BAR;
    PG8_WAIT_V(4); PG8_BAR;
    PG8_STAGE(PG8_SB(1, 0), cB + kstep, voffA); STG_A(PG8_SA(1, 0), kstep, 0, false); PG8_STAGE(PG8_SB(1, 1), cB + hstep + kstep, voffA);
    PG8_WAIT_V(6); PG8_BAR;
    for (;;) {
        const bool has_next = S.next(ui + 1, nxt);
        nA = has_next ? (const char*)A + (size_t)nxt.arow * rstep : cA; const char* nB = has_next ? (const char*)Bt + (size_t)nxt.brow * rstep : cB;
        if constexpr (GATHER) { if (has_next) load_off(nxt.arow, noff); else {
#pragma unroll
            for (int h = 0; h < 2; ++h) { noff[h][0] = coff[h][0]; noff[h][1] = coff[h][1]; } } }
        for (int t = 0; t < nt; t += 2) {
            const bool last = (t == nt - 2);
            const size_t k1 = (size_t)(t + 1) * kstep, k2 = last ? (size_t)0 : (size_t)(t + 2) * kstep, k3 = k2 + kstep;
            const char* b2 = last ? nB : cB + (size_t)(t + 2) * kstep;
            const char* b3 = b2 + kstep;
            PG8_LDB(B0, 0, 0); PG8_SCHED; PG8_LDA(At, 0, 0); STG_A(PG8_SA(1, 1), k1, 1, false);
            PG8_WAIT_L(8); PG8_BAR; PG8_WAIT_L(0); PG8_MMA(0, 0, At, B0); PG8_BAR; PG8_SCHED;
            PG8_LDB(B1, 0, 1); PG8_STAGE(PG8_SB(0, 0), b2, voffA);
            PG8_BAR; PG8_WAIT_L(0); PG8_MMA(0, 1, At, B1); PG8_BAR;
            PG8_LDA(At, 0, 1); STG_A(PG8_SA(0, 0), k2, 0, last);
            PG8_BAR; PG8_WAIT_L(0); PG8_MMA(1, 0, At, B0); PG8_BAR; PG8_SCHED;
            PG8_STAGE(PG8_SB(0, 1), b2 + hstep, voffA);
            PG8_WAIT_V(6); PG8_BAR; PG8_MMA(1, 1, At, B1); PG8_BAR;
            PG8_LDB(B0, 1, 0); PG8_SCHED; PG8_LDA(At, 1, 0); STG_A(PG8_SA(0, 1), k2, 1, last);
            PG8_WAIT_L(8); PG8_BAR; PG8_WAIT_L(0); PG8_MMA(0, 0, At, B0); PG8_BAR; PG8_SCHED;
            PG8_LDB(B1, 1, 1); PG8_STAGE(PG8_SB(1, 0), b3, voffA);
            PG8_BAR; PG8_WAIT_L(0); PG8_MMA(0, 1, At, B1); PG8_BAR;
            PG8_LDA(At, 1, 1); STG_A(PG8_SA(1, 0), k3, 0, last);
            PG8_BAR; PG8_WAIT_L(0); PG8_MMA(1, 0, At, B0); PG8_BAR; PG8_SCHED;
            PG8_STAGE(PG8_SB(1, 1), b3 + hstep, voffA);
            PG8_WAIT_V(6); PG8_BAR; PG8_MMA(1, 1, At, B1); PG8_BAR;
        }
        E(acc, cur, wr, wc, fr, fq);
        if (!has_next) break;
#pragma unroll
        for (int a = 0; a < 2; ++a)
#pragma unroll
            for (int b = 0; b < 2; ++b)
#pragma unroll
                for (int m = 0; m < 4; ++m)
#pragma unroll
                    for (int n = 0; n < 2; ++n) acc[a][b][m][n] = (f32x4){0.f, 0.f, 0.f, 0.f};
        cur = nxt; cA = nA; cB = nB; ++ui;
        if constexpr (GATHER) {
#pragma unroll
            for (int h = 0; h < 2; ++h) { coff[h][0] = noff[h][0]; coff[h][1] = noff[h][1]; } }
    }
    PG8_WAIT_V(0);
    if (wr == 0) PG8_BAR;
    PG8_BAR;
#undef PG8_SA
#undef PG8_SB
#undef PG8_STAGE
#undef STG_A
#undef PG8_LDA
#undef PG8_LDB
#undef PG8_MMA
#undef PG8_WAIT_V
#undef PG8_WAIT_L
#undef PG8_BAR
#undef PG8_SCHED
}

typedef const f32x4 (&AccRef)[2][2][4][2];

struct EpiQKV0 {
    bf16_t* O; const float* qn; const float* kn;
    const float *rc, *rs, *cc, *cs, *sc, *ss;
    __device__ __forceinline__ void operator()(AccRef acc, const Unit& u, int wr, int wc, int fr, int fq) const {
        const int head = 4 * u.pn + wc;
        const int type = head < 10 ? 0 : ((head >= 12 && head < 22) ? 1 : 2);
        float gain[2][8];
        if (type == 0) { const float* gp = head < 8 ? qn : kn;
#pragma unroll
            for (int bj = 0; bj < 2; ++bj)
#pragma unroll
                for (int j = 0; j < 8; ++j) gain[bj][j] = gp[bj * 32 + (j & 1) * 16 + 4 * fq + (j >> 1)]; }
        const int rowb = u.orow + 64 * wr + fr;
        f32x4 tc[4] = {}, tn[4] = {};
        auto ldtab = [&](f32x4 (&t)[4], int g) {
            const int s = (rowb + 128 * (g >> 2) + 16 * (g & 3)) & (SEQ - 1);
            if (type == 0) { t[0] = *(const f32x4*)(rc + (s >> 6) * 16 + 4 * fq); t[1] = *(const f32x4*)(rs + (s >> 6) * 16 + 4 * fq);
                             t[2] = *(const f32x4*)(cc + (s & 63) * 16 + 4 * fq); t[3] = *(const f32x4*)(cs + (s & 63) * 16 + 4 * fq); }
            else { t[0] = *(const f32x4*)(sc + s * 32 + 4 * fq); t[1] = *(const f32x4*)(ss + s * 32 + 4 * fq);
                   t[2] = *(const f32x4*)(sc + s * 32 + 16 + 4 * fq); t[3] = *(const f32x4*)(ss + s * 32 + 16 + 4 * fq); }
        };
        if (type != 2) ldtab(tc, 0);
        const float qs = (head < 8 || (head >= 12 && head < 20)) ? 0.18033688011112042f : 1.f;
#pragma unroll
        for (int g = 0; g < 8; ++g) {
            const int ai = g >> 2, m = g & 3;
            const int row = rowb + 128 * ai + 16 * m;
            if (type != 2 && g + 1 < 8) ldtab(tn, g + 1);
            float v[2][8];
#pragma unroll
            for (int bj = 0; bj < 2; ++bj)
#pragma unroll
                for (int n = 0; n < 2; ++n)
#pragma unroll
                    for (int i = 0; i < 4; ++i) v[bj][4 * n + i] = acc[ai][bj][m][n][i];
            if (type == 0) {
                float sq = 0.f;
#pragma unroll
                for (int bj = 0; bj < 2; ++bj)
#pragma unroll
                    for (int j = 0; j < 8; ++j) sq += v[bj][j] * v[bj][j];
                sq += __shfl_xor(sq, 16); sq += __shfl_xor(sq, 32);
                const float rinv = rsqrtf(sq * (1.f / 64.f) + 1e-6f);
#pragma unroll
                for (int bj = 0; bj < 2; ++bj)
#pragma unroll
                    for (int j = 0; j < 8; ++j) v[bj][j] = v[bj][j] * rinv * gain[bj][j];
            }
            if (type != 2) {
#pragma unroll
                for (int bj = 0; bj < 2; ++bj) {
                    const f32x4 cv = tc[2 * bj], sv = tc[2 * bj + 1];
#pragma unroll
                    for (int jj = 0; jj < 4; ++jj) { const float x1 = v[bj][2 * jj], x2 = v[bj][2 * jj + 1];
                        v[bj][2 * jj] = x1 * cv[jj] - x2 * sv[jj]; v[bj][2 * jj + 1] = x2 * cv[jj] + x1 * sv[jj]; }
                }
            }
#pragma unroll
            for (int bj = 0; bj < 2; ++bj) {
                u32x4 w = {cvtpk(v[bj][0] * qs, v[bj][1] * qs), cvtpk(v[bj][2] * qs, v[bj][3] * qs), cvtpk(v[bj][4] * qs, v[bj][5] * qs), cvtpk(v[bj][6] * qs, v[bj][7] * qs)};
                *(u32x4*)(O + (size_t)row * 1536 + head * 64 + 32 * bj + 8 * fq) = w;
            }
#pragma unroll
            for (int k = 0; k < 4; ++k) tc[k] = tn[k];
        }
    }
};

struct EpiRes {
    const float* res; float* out;
    __device__ __forceinline__ void operator()(AccRef acc, const Unit& u, int wr, int wc, int fr, int fq) const {
        const size_t row0 = (size_t)(u.orow + 64 * wr + fr); const int col0 = 256 * u.pn + 32 * wc + 4 * fq;
        f32x4 rc[4], rn[4];
#pragma unroll
        for (int k = 0; k < 4; ++k) rc[k] = *(const f32x4*)(res + row0 * 1024 + col0 + 128 * (k >> 1) + 16 * (k & 1));
#pragma unroll
        for (int g = 0; g < 8; ++g) {
            const int ai = g >> 2, m = g & 3;
            if (g + 1 < 8) { const size_t rown = row0 + 128 * ((g + 1) >> 2) + 16 * ((g + 1) & 3);
#pragma unroll
                for (int k = 0; k < 4; ++k) rn[k] = *(const f32x4*)(res + rown * 1024 + col0 + 128 * (k >> 1) + 16 * (k & 1)); }
            const size_t row = row0 + 128 * ai + 16 * m;
#pragma unroll
            for (int k = 0; k < 4; ++k) *(f32x4*)(out + row * 1024 + col0 + 128 * (k >> 1) + 16 * (k & 1)) = rc[k] * ALPHA + acc[ai][k >> 1][m][k & 1];
#pragma unroll
            for (int k = 0; k < 4; ++k) rc[k] = rn[k];
        }
    }
};
struct EpiF32 {
    float* out; int ldc;
    __device__ __forceinline__ void operator()(AccRef acc, const Unit& u, int wr, int wc, int fr, int fq) const {
#pragma unroll
        for (int ai = 0; ai < 2; ++ai)
#pragma unroll
            for (int m = 0; m < 4; ++m) {
                const size_t row = (size_t)(u.orow + 128 * ai + 64 * wr + 16 * m + fr);
#pragma unroll
                for (int bj = 0; bj < 2; ++bj)
#pragma unroll
                    for (int n = 0; n < 2; ++n) {
                        const int col = 256 * u.pn + 128 * bj + 32 * wc + 16 * n + 4 * fq;
                        *(f32x4*)(out + row * ldc + col) = acc[ai][bj][m][n];
                    }
            }
    }
};
struct EpiSwiGLU {
    bf16_t* H;
    __device__ __forceinline__ void operator()(AccRef acc, const Unit& u, int wr, int wc, int fr, int fq) const {
#pragma unroll
        for (int ai = 0; ai < 2; ++ai)
#pragma unroll
            for (int m = 0; m < 4; ++m) {
                const size_t row = (size_t)(u.orow + 128 * ai + 64 * wr + 16 * m + fr);
                float h[8];
#pragma unroll
                for (int n = 0; n < 2; ++n)
#pragma unroll
                    for (int i = 0; i < 4; ++i) { const float g = acc[ai][0][m][n][i], up = acc[ai][1][m][n][i];
                        h[4 * n + i] = g * __builtin_amdgcn_rcpf(1.f + __builtin_amdgcn_exp2f(-g * 1.4426950408889634f)) * up; }
                u32x4 w = {cvtpk(h[0], h[1]), cvtpk(h[2], h[3]), cvtpk(h[4], h[5]), cvtpk(h[6], h[7])};
                *(u32x4*)(H + row * 1024 + 128 * u.pn + 32 * wc + 8 * fq) = w;
            }
    }
};
template <int MODE  >
struct EpiBf16 {
    bf16_t* O; int ldc; const float* rowscale; const float* mc; const float* ms;
    __device__ __forceinline__ void operator()(AccRef acc, const Unit& u, int wr, int wc, int fr, int fq) const {
        const int rowb = u.orow + 64 * wr + fr;
        float scv[8];
#pragma unroll
        for (int g = 0; g < 8; ++g) scv[g] = (MODE == 1) ? rowscale[(size_t)(rowb + 128 * (g >> 2) + 16 * (g & 3))] : (MODE == 2 ? 0.14724508409f : 1.f);
        bool rp[2] = {false, false};
        if (MODE == 2) { rp[0] = ((8 * u.pn + wc) % 3) == 2; rp[1] = ((8 * u.pn + 4 + wc) % 3) == 2; }
        const bool anyrope = (MODE == 2) && (rp[0] || rp[1]);
        f32x4 cvc = {}, svc = {}, cvn = {}, svn = {};
        if (anyrope) { const int s0 = rowb & (SEQ - 1); cvc = *(const f32x4*)(mc + s0 * 16 + 4 * fq); svc = *(const f32x4*)(ms + s0 * 16 + 4 * fq); }
#pragma unroll
        for (int g = 0; g < 8; ++g) {
            const int ai = g >> 2, m = g & 3;
            const int rowi = rowb + 128 * ai + 16 * m; const size_t row = (size_t)rowi;
            if (anyrope && g + 1 < 8) { const int sn = (rowb + 128 * ((g + 1) >> 2) + 16 * ((g + 1) & 3)) & (SEQ - 1);
                cvn = *(const f32x4*)(mc + sn * 16 + 4 * fq); svn = *(const f32x4*)(ms + sn * 16 + 4 * fq); }
            const float sc = scv[g];
#pragma unroll
            for (int bj = 0; bj < 2; ++bj) {
                float v[8];
#pragma unroll
                for (int n = 0; n < 2; ++n)
#pragma unroll
                    for (int i = 0; i < 4; ++i) v[4 * n + i] = acc[ai][bj][m][n][i] * sc;
                if (MODE == 2) {
                    if (rp[bj]) {
#pragma unroll
                        for (int jj = 0; jj < 4; ++jj) { const float x1 = v[2 * jj], x2 = v[2 * jj + 1];
                            v[2 * jj] = x1 * cvc[jj] - x2 * svc[jj]; v[2 * jj + 1] = x2 * cvc[jj] + x1 * svc[jj]; }
                    }
                }
                u32x4 w = {cvtpk(v[0], v[1]), cvtpk(v[2], v[3]), cvtpk(v[4], v[5]), cvtpk(v[6], v[7])};
                *(u32x4*)(O + row * ldc + 256 * u.pn + 128 * bj + 32 * wc + 8 * fq) = w;
            }
            cvc = cvn; svc = svn;
        }
    }
};

#define SBAR() __builtin_amdgcn_sched_barrier(0)
__device__ __forceinline__ int crow(int r, int hi) { return (r & 3) + 8 * (r >> 2) + 4 * hi; }
template <int DQ> struct ACfg {
    static constexpr int KROW = DQ * 2 + 16, SHM_K = 64 * KROW, SHM_V = 64 * 64 * 2, ND = DQ / 16;
    static constexpr float SCALE = DQ == 64 ? 0.125f : 0.10206207261596575f;
};
constexpr float ATT_THR = 8.f;

#ifndef ATT_GUARD
#define ATT_GUARD 1.0e30f
#endif
__device__ __forceinline__ void win_mask(f32x16& p0, f32x16& p1, int dlt, int hi) {
#pragma unroll
    for (int r = 0; r < 16; ++r) { const int d0 = dlt - crow(r, hi), d1 = d0 - 32;
        if (d0 > 128 || d0 < -128) p0[r] = -INFINITY;
        if (d1 > 128 || d1 < -128) p1[r] = -INFINITY; }
}
__device__ __forceinline__ float row_max32(const f32x16& p0, const f32x16& p1) {
    float pmax = p0[0];
#pragma unroll
    for (int r = 1; r < 16; ++r) pmax = fmaxf(pmax, p0[r]);
#pragma unroll
    for (int r = 0; r < 16; ++r) pmax = fmaxf(pmax, p1[r]);
    auto rr = __builtin_amdgcn_permlane32_swap(__float_as_uint(pmax), __float_as_uint(pmax), false, false);
    return fmaxf(__uint_as_float(rr[0]), __uint_as_float(rr[1]));
}
__device__ __forceinline__ float row_sum32_half(const f32x16& p0, const f32x16& p1) {
    float ps = 0;
#pragma unroll
    for (int r = 0; r < 16; ++r) ps += p0[r];
#pragma unroll
    for (int r = 0; r < 16; ++r) ps += p1[r];
    return ps;
}
__device__ __forceinline__ void exp16(f32x16& p) {
#pragma unroll
    for (int r = 0; r < 16; ++r) p[r] = __builtin_amdgcn_exp2f(p[r]);
}
__device__ __forceinline__ void pack_p(const f32x16& p0, const f32x16& p1, bf16x8& pa0, bf16x8& pa1, bf16x8& pa2, bf16x8& pa3) {
#define PK4(P, BASE, OUT) do { unsigned a0 = cvtpk(P[BASE + 0], P[BASE + 1]), a1 = cvtpk(P[BASE + 2], P[BASE + 3]);   \
    unsigned b0 = cvtpk(P[BASE + 4], P[BASE + 5]), b1 = cvtpk(P[BASE + 6], P[BASE + 7]);                              \
    auto r0 = __builtin_amdgcn_permlane32_swap(a0, b0, false, false); auto r1 = __builtin_amdgcn_permlane32_swap(a1, b1, false, false); \
    u32x4 w = {r0[0], r1[0], r0[1], r1[1]}; OUT = *reinterpret_cast<bf16x8*>(&w); } while (0)
    PK4(p0, 0, pa0); PK4(p0, 8, pa1); PK4(p1, 0, pa2); PK4(p1, 8, pa3);
#undef PK4
}
__device__ __forceinline__ void pack_p_ns(const f32x16& p0, const f32x16& p1, bf16x8& pa0, bf16x8& pa1, bf16x8& pa2, bf16x8& pa3) {
#define PK8(P, BASE, OUT) do { u32x4 w = {cvtpk(P[BASE + 0], P[BASE + 1]), cvtpk(P[BASE + 2], P[BASE + 3]), cvtpk(P[BASE + 4], P[BASE + 5]), cvtpk(P[BASE + 6], P[BASE + 7])}; \
    OUT = *reinterpret_cast<bf16x8*>(&w); } while (0)
    PK8(p0, 0, pa0); PK8(p0, 8, pa1); PK8(p1, 0, pa2); PK8(p1, 8, pa3);
#undef PK8
}
template <int DQ>
__device__ __forceinline__ void qkt(f32x16& p0, f32x16& p1, const char* Ks, const bf16x8* qr, const f32x16& ci, int r32, int hi) {
    constexpr int KROW = ACfg<DQ>::KROW;
#pragma unroll
    for (int d0 = 0; d0 < ACfg<DQ>::ND; ++d0) { const int cb = (d0 * 16 + hi * 8) * 2;
        bf16x8 b0 = *reinterpret_cast<const bf16x8*>(Ks + r32 * KROW + cb);
        bf16x8 b1 = *reinterpret_cast<const bf16x8*>(Ks + (32 + r32) * KROW + cb);
        p0 = __builtin_amdgcn_mfma_f32_32x32x16_bf16(b0, qr[d0], d0 == 0 ? ci : p0, 0, 0, 0);
        p1 = __builtin_amdgcn_mfma_f32_32x32x16_bf16(b1, qr[d0], d0 == 0 ? ci : p1, 0, 0, 0); }
}
__device__ __forceinline__ int v_st(int k, int c) { const int kk = (k & ~0xC) | ((k & 4) << 1) | ((k & 8) >> 1); return ((kk >> 3) * 2 + (c >> 5)) * 512 + ((kk & 7) * 32 + (c & 31)) * 2; }
__device__ __forceinline__ int v_st_ns(int k, int c) { return ((k >> 3) * 2 + (c >> 5)) * 512 + ((k & 7) * 32 + (c & 31)) * 2; }
__device__ __forceinline__ int v_rd_base(int lane) { return ((lane & 3) << 3) | (((lane >> 2) & 3) << 6) | (((lane >> 4) & 1) << 5) | (((lane >> 5) & 1) << 8); }
constexpr int v_rd_off(int d0, int ks, int half) { return d0 * 512 + ks * 2048 + half * 1024; }
template <int OFF> __device__ __forceinline__ s16x4 tr_read(int vb) {
    s16x4 r; asm volatile("ds_read_b64_tr_b16 %0, %1 offset:%2" : "=&v"(r) : "v"(vb), "i"(OFF) : "memory"); return r;
}
template <int D0> __device__ __forceinline__ void pv_one(f32x16& od, int vb, bf16x8 pa0, bf16x8 pa1, bf16x8 pa2, bf16x8 pa3) {
    const s16x4 l0 = tr_read<v_rd_off(D0, 0, 0)>(vb), h0 = tr_read<v_rd_off(D0, 0, 1)>(vb), l1 = tr_read<v_rd_off(D0, 1, 0)>(vb), h1 = tr_read<v_rd_off(D0, 1, 1)>(vb);
    const s16x4 l2 = tr_read<v_rd_off(D0, 2, 0)>(vb), h2 = tr_read<v_rd_off(D0, 2, 1)>(vb), l3 = tr_read<v_rd_off(D0, 3, 0)>(vb), h3 = tr_read<v_rd_off(D0, 3, 1)>(vb);
    asm volatile("s_waitcnt lgkmcnt(0)" ::: "memory"); SBAR();
#define PK(L, H) (bf16x8){L[0], L[1], L[2], L[3], H[0], H[1], H[2], H[3]}
    od = __builtin_amdgcn_mfma_f32_32x32x16_bf16(pa0, PK(l0, h0), od, 0, 0, 0);
    od = __builtin_amdgcn_mfma_f32_32x32x16_bf16(pa1, PK(l1, h1), od, 0, 0, 0);
    od = __builtin_amdgcn_mfma_f32_32x32x16_bf16(pa2, PK(l2, h2), od, 0, 0, 0);
    od = __builtin_amdgcn_mfma_f32_32x32x16_bf16(pa3, PK(l3, h3), od, 0, 0, 0);
#undef PK
}
__device__ __forceinline__ void pv_d0(f32x16* o, int vb, bf16x8 pa0, bf16x8 pa1, bf16x8 pa2, bf16x8 pa3) {
    pv_one<0>(o[0], vb, pa0, pa1, pa2, pa3); pv_one<1>(o[1], vb, pa0, pa1, pa2, pa3);
}

template <int DQ, bool WIN>
__device__ __forceinline__ void partialSM_s(f32x16& p0, f32x16& p1, float& m_reg, float& mn, float& alpha, int dlt, int hi) {
    constexpr float C = 1.0f, SCALE = 1.0f / 1.4426950408889634f;
    if (WIN) {
#pragma unroll
        for (int r = 0; r < 16; ++r) { const int d0 = dlt - crow(r, hi), d1 = d0 - 32;
            if (d0 > 128 || d0 < -128) p0[r] = -INFINITY;
            if (d1 > 128 || d1 < -128) p1[r] = -INFINITY; }
    }
    float pmax = p0[0];
#pragma unroll
    for (int r = 1; r < 16; ++r) pmax = fmaxf(pmax, p0[r]);
#pragma unroll
    for (int r = 0; r < 16; ++r) pmax = fmaxf(pmax, p1[r]);
    { auto rr = __builtin_amdgcn_permlane32_swap(__float_as_uint(pmax), __float_as_uint(pmax), false, false);
      pmax = fmaxf(__uint_as_float(rr[0]), __uint_as_float(rr[1])); }
    if (__builtin_expect(__all(pmax - m_reg <= ATT_THR / SCALE), 1)) { mn = m_reg; alpha = 1.f; }
    else { mn = fmaxf(m_reg, pmax); alpha = __builtin_amdgcn_exp2f((m_reg - mn) * C); m_reg = mn; }
    const float mnC = -mn * C;
#pragma unroll
    for (int r = 0; r < 16; ++r) p0[r] = fmaf(p0[r], C, mnC);
#pragma unroll
    for (int r = 0; r < 16; ++r) p1[r] = fmaf(p1[r], C, mnC);
#pragma unroll
    for (int r = 0; r < 16; ++r) p0[r] = __builtin_amdgcn_exp2f(p0[r]);
}
__device__ __forceinline__ void finishSM_s(f32x16& p0, f32x16& p1, float alpha, float& l_reg, bf16x8& pa0, bf16x8& pa1, bf16x8& pa2, bf16x8& pa3) {
#pragma unroll
    for (int r = 0; r < 16; ++r) p1[r] = __builtin_amdgcn_exp2f(p1[r]);
    float ps = 0;
#pragma unroll
    for (int r = 0; r < 16; ++r) ps += p0[r];
#pragma unroll
    for (int r = 0; r < 16; ++r) ps += p1[r];
    { auto rr = __builtin_amdgcn_permlane32_swap(__float_as_uint(ps), __float_as_uint(ps), false, false);
      ps = __uint_as_float(rr[0]) + __uint_as_float(rr[1]); }
    l_reg = l_reg * alpha + ps;
#define PK4(P, BASE, OUT) do { unsigned a0 = cvtpk(P[BASE + 0], P[BASE + 1]), a1 = cvtpk(P[BASE + 2], P[BASE + 3]);   \
    unsigned b0 = cvtpk(P[BASE + 4], P[BASE + 5]), b1 = cvtpk(P[BASE + 6], P[BASE + 7]);                              \
    auto r0 = __builtin_amdgcn_permlane32_swap(a0, b0, false, false); auto r1 = __builtin_amdgcn_permlane32_swap(a1, b1, false, false); \
    u32x4 w = {r0[0], r1[0], r0[1], r1[1]}; OUT = *reinterpret_cast<bf16x8*>(&w); } while (0)
    PK4(p0, 0, pa0); PK4(p0, 8, pa1); PK4(p1, 0, pa2); PK4(p1, 8, pa3);
#undef PK4
}
template <int DQ>
__device__ __forceinline__ void qkt_s(f32x16& p0, f32x16& p1, const char* Ks, const bf16x8* qr, int r32, int hi) {
    constexpr int KROW = ACfg<DQ>::KROW;
    p0 = f32x16{}; p1 = f32x16{};
#pragma unroll
    for (int d0 = 0; d0 < ACfg<DQ>::ND; ++d0) { const int cb = (d0 * 16 + hi * 8) * 2;
        bf16x8 b0 = *reinterpret_cast<const bf16x8*>(Ks + r32 * KROW + cb);
        bf16x8 b1 = *reinterpret_cast<const bf16x8*>(Ks + (32 + r32) * KROW + cb);
        p0 = __builtin_amdgcn_mfma_f32_32x32x16_bf16(b0, qr[d0], p0, 0, 0, 0);
        p1 = __builtin_amdgcn_mfma_f32_32x32x16_bf16(b1, qr[d0], p1, 0, 0, 0); }
}

template <int DQ, bool WIN, int LDQ, int LDK>
__device__ __forceinline__ void attn_body_safe(const bf16_t* __restrict__ Qb, const bf16_t* __restrict__ Kh, const bf16_t* __restrict__ Kr, const bf16_t* __restrict__ Vh,
                                          bf16_t* __restrict__ Ob, int kt0, int NT, int q0, float sink_l2, char* lds) {
    constexpr int KROW = ACfg<DQ>::KROW, SHM_K = ACfg<DQ>::SHM_K, SHM_V = ACfg<DQ>::SHM_V, ND = ACfg<DQ>::ND;
    constexpr int LDO = 1024;
    constexpr float C = 1.0f;
    const int tid = otid(), wid = __builtin_amdgcn_readfirstlane(tid >> 6), lane = tid & 63, r32 = lane & 31, hi = lane >> 5;
    char* V_lds = lds; char* K_lds = lds + 2 * SHM_V;
    float* wsf = (float*)(lds + 2 * SHM_V + 2 * SHM_K) + wid * 64; float* li_l = wsf; float* al_l = wsf + 32;
    float m_reg = -1e30f, l_reg = 0; f32x16 o[2] = {}; bf16x8 qr[ND];
    const bf16_t* Qw = Qb + (size_t)(wid * 32 + r32) * LDQ + hi * 8;
#pragma unroll
    for (int d0 = 0; d0 < ND; ++d0) qr[d0] = *reinterpret_cast<const bf16x8*>(Qw + d0 * 16);
    const int sr = tid >> 3, sc = (tid & 7) * 8, vst0 = v_st(sr, sc);
    const int kst0 = sr * KROW + sc * 2;
    const int sr2 = (tid & 255) >> 2, sc2 = (tid & 3) * 8; const int kst2 = sr2 * KROW + 128 + sc2 * 2;
    const int vb0 = (int)(uintptr_t)V_lds + v_rd_base(lane);
    const int qrow = q0 + wid * 32 + r32;
    struct { bf16x8 vs, ks, kr; } st_[2];
#define SLOAD(i, k0) do { st_[i].vs = *reinterpret_cast<const bf16x8*>(&Vh[(size_t)((k0) + sr) * LDK + sc]); \
    st_[i].ks = *reinterpret_cast<const bf16x8*>(&Kh[(size_t)((k0) + sr) * LDK + sc]); \
    if (DQ == 96) st_[i].kr = *reinterpret_cast<const bf16x8*>(&Kr[(size_t)((k0) + sr2) * 32 + sc2]); } while (0)
#define SWRITE(b, i) do { *(bf16x8*)(V_lds + (b) * SHM_V + vst0) = st_[i].vs; *(bf16x8*)(K_lds + (b) * SHM_K + kst0) = st_[i].ks; \
    if (DQ == 96) { if (tid < 256) *(bf16x8*)(K_lds + (b) * SHM_K + kst2) = st_[i].kr; } } while (0)
#define SWAIT() do { if (DQ == 96) asm volatile("s_waitcnt vmcnt(3)" ::: "memory"); else asm volatile("s_waitcnt vmcnt(2)" ::: "memory"); } while (0)
#define RESC(a) do { if (__any((a) < 1.f)) { if (hi == 0) al_l[r32] = (a); asm volatile("s_waitcnt lgkmcnt(0)" ::: "memory"); \
    _Pragma("unroll") for (int d = 0; d < 2; ++d) _Pragma("unroll") for (int r = 0; r < 16; ++r) o[d][r] *= al_l[crow(r, hi)]; } } while (0)
#define KBASE(j) ((kt0 + (j)) * 64)
    f32x16 pA0, pA1, pB0, pB1; float mnA, mnB, alA, alB; bf16x8 pa0, pa1, pa2, pa3;
    constexpr int SE = 0, SO = 1;
    SLOAD(SE, KBASE(0)); asm volatile("s_waitcnt vmcnt(0)" ::: "memory"); SWRITE(0, SE); __syncthreads();
    qkt_s<DQ>(pA0, pA1, K_lds, qr, r32, hi); partialSM_s<DQ, WIN>(pA0, pA1, m_reg, mnA, alA, qrow - KBASE(0), hi);
    SLOAD(SO, KBASE(1)); if (2 < NT) SLOAD(SE, KBASE(2));
    SWAIT(); SWRITE(1, SO); __syncthreads();
    for (int j = 1; j + 1 < NT; j += 2) {
        SBAR(); qkt_s<DQ>(pB0, pB1, K_lds + SHM_K, qr, r32, hi);
        finishSM_s(pA0, pA1, alA, l_reg, pa0, pa1, pa2, pa3); SBAR();
        SLOAD(SO, KBASE(j + 2)); SBAR();
        pv_d0(o, vb0, pa0, pa1, pa2, pa3); partialSM_s<DQ, WIN>(pB0, pB1, m_reg, mnB, alB, qrow - KBASE(j), hi);
        __syncthreads(); SWAIT(); SWRITE(0, SE);
        RESC(alB); __syncthreads();
        SBAR(); qkt_s<DQ>(pA0, pA1, K_lds, qr, r32, hi);
        finishSM_s(pB0, pB1, alB, l_reg, pa0, pa1, pa2, pa3); SBAR();
        if (j + 3 < NT) SLOAD(SE, KBASE(j + 3)); SBAR();
        pv_d0(o, vb0 + SHM_V, pa0, pa1, pa2, pa3); partialSM_s<DQ, WIN>(pA0, pA1, m_reg, mnA, alA, qrow - KBASE(j + 1), hi);
        __syncthreads(); SWAIT(); SWRITE(1, SO);
        RESC(alA); __syncthreads();
    }
    SBAR(); qkt_s<DQ>(pB0, pB1, K_lds + SHM_K, qr, r32, hi);
    finishSM_s(pA0, pA1, alA, l_reg, pa0, pa1, pa2, pa3); SBAR();
    pv_d0(o, vb0, pa0, pa1, pa2, pa3); partialSM_s<DQ, WIN>(pB0, pB1, m_reg, mnB, alB, qrow - KBASE(NT - 1), hi);
    __syncthreads(); RESC(alB);
    finishSM_s(pB0, pB1, alB, l_reg, pa0, pa1, pa2, pa3); SBAR();
    pv_d0(o, vb0 + SHM_V, pa0, pa1, pa2, pa3);
    if (WIN) l_reg += __builtin_amdgcn_exp2f(sink_l2 - m_reg * C);
    if (hi == 0) li_l[r32] = l_reg; asm volatile("s_waitcnt lgkmcnt(0)" ::: "memory");
    float rli[16];
#pragma unroll
    for (int r = 0; r < 16; ++r) rli[r] = __builtin_amdgcn_rcpf(li_l[crow(r, hi)]);
    bf16_t* Ow = Ob + (size_t)(wid * 32) * LDO;
#pragma unroll
    for (int r = 0; r < 16; ++r) { const int orow = crow(r, hi);
#pragma unroll
        for (int d0 = 0; d0 < 2; ++d0) Ow[(size_t)orow * LDO + d0 * 32 + r32] = (bf16_t)(cvtpk(o[d0][r] * rli[r], 0.f) & 0xffffu); }
    __syncthreads();
#undef SLOAD
#undef SWRITE
#undef SWAIT
#undef RESC
#undef KBASE
}


template <int DQ, bool WIN, int LDQ, int LDK>
__device__ __forceinline__ int attn_body(const bf16_t* __restrict__ Qb, const bf16_t* __restrict__ Kh, const bf16_t* __restrict__ Kr, const bf16_t* __restrict__ Vh,
                                          bf16_t* __restrict__ Ob, int kt0, int NT, int q0, float sink_l2, char* lds) {
    constexpr int KROW = ACfg<DQ>::KROW, SHM_K = ACfg<DQ>::SHM_K, SHM_V = ACfg<DQ>::SHM_V, ND = ACfg<DQ>::ND;
    constexpr int LDO = 1024;
    const int tid = otid(), wid = __builtin_amdgcn_readfirstlane(tid >> 6), lane = tid & 63, r32 = lane & 31, hi = lane >> 5;
    char* V_lds = lds; char* K_lds = lds + 2 * SHM_V;
    float* wsf = (float*)(lds + 2 * SHM_V + 2 * SHM_K) + wid * 64; float* li_l = wsf;
    volatile int* redo_flag = (volatile int*)(lds + 2 * SHM_V + 2 * SHM_K + 8 * 64 * 4);
    if (tid == 0) *redo_flag = 0;
    float m_ref = 0.f; f32x16 o[2] = {}; f32x16 lsum = {}; f32x16 minit; bf16x8 qr[ND];
    const bf16x8 ones8 = {(short)0x3F80, (short)0x3F80, (short)0x3F80, (short)0x3F80, (short)0x3F80, (short)0x3F80, (short)0x3F80, (short)0x3F80};
    const f32x16 zero16 = {};
    const bf16_t* Qw = Qb + (size_t)(wid * 32 + r32) * LDQ + hi * 8;
#pragma unroll
    for (int d0 = 0; d0 < ND; ++d0) qr[d0] = *reinterpret_cast<const bf16x8*>(Qw + d0 * 16);
    const int sr = tid >> 3, sc = (tid & 7) * 8, vst0 = v_st_ns(sr, sc);
    const int kst0 = sr * KROW + sc * 2;
    const int sr2 = (tid & 255) >> 2, sc2 = (tid & 3) * 8; const int kst2 = sr2 * KROW + 128 + sc2 * 2;
    const int vb0 = (int)(uintptr_t)V_lds + v_rd_base(lane);
    const int qrow = q0 + wid * 32 + r32;
    struct { bf16x8 vs, ks, kr; } st_[2];
#define SLOAD(i, k0) do { st_[i].vs = *reinterpret_cast<const bf16x8*>(&Vh[(size_t)((k0) + sr) * LDK + sc]); \
    st_[i].ks = *reinterpret_cast<const bf16x8*>(&Kh[(size_t)((k0) + sr) * LDK + sc]); \
    if (DQ == 96) st_[i].kr = *reinterpret_cast<const bf16x8*>(&Kr[(size_t)((k0) + sr2) * 32 + sc2]); } while (0)
#define SWRITE(b, i) do { *(bf16x8*)(V_lds + (b) * SHM_V + vst0) = st_[i].vs; *(bf16x8*)(K_lds + (b) * SHM_K + kst0) = st_[i].ks; \
    if (DQ == 96) { if (tid < 256) *(bf16x8*)(K_lds + (b) * SHM_K + kst2) = st_[i].kr; } } while (0)
#define SWAIT() do { if (DQ == 96) asm volatile("s_waitcnt vmcnt(3)" ::: "memory"); else asm volatile("s_waitcnt vmcnt(2)" ::: "memory"); } while (0)
#define KBASE(j) ((kt0 + (j)) * 64)
    f32x16 pA0, pA1, pB0, pB1; bf16x8 pa0, pa1, pa2, pa3;
    auto finish = [&](f32x16& p0, f32x16& p1) {
        exp16(p1);
        pack_p_ns(p0, p1, pa0, pa1, pa2, pa3);
    };
    auto pv = [&](int vb) {
        pv_d0(o, vb, pa0, pa1, pa2, pa3);
    };
    auto lsum_upd = [&]() {
        lsum = __builtin_amdgcn_mfma_f32_32x32x16_bf16(pa0, ones8, lsum, 0, 0, 0);
        lsum = __builtin_amdgcn_mfma_f32_32x32x16_bf16(pa1, ones8, lsum, 0, 0, 0);
        lsum = __builtin_amdgcn_mfma_f32_32x32x16_bf16(pa2, ones8, lsum, 0, 0, 0);
        lsum = __builtin_amdgcn_mfma_f32_32x32x16_bf16(pa3, ones8, lsum, 0, 0, 0);
    };
    constexpr int SE = 0, SO = 1;
    SLOAD(SE, KBASE(0)); SLOAD(SO, KBASE(1));
    SWAIT(); SWRITE(0, SE); __syncthreads();
    qkt<DQ>(pA0, pA1, K_lds, qr, zero16, r32, hi);
    if (WIN) win_mask(pA0, pA1, qrow - KBASE(0), hi);
    { const float pm = row_max32(pA0, pA1); m_ref = (pm > -1e37f) ? pm : 0.f;
#pragma unroll
      for (int r = 0; r < 16; ++r) { minit[r] = -m_ref; pA0[r] -= m_ref; pA1[r] -= m_ref; } }
    exp16(pA0);
    if (2 < NT) SLOAD(SE, KBASE(2));
    SWAIT(); SWRITE(1, SO); __syncthreads();
#pragma unroll 1
    for (int j = 1; j + 1 < NT; j += 2) {
        SBAR(); qkt<DQ>(pB0, pB1, K_lds + SHM_K, qr, minit, r32, hi);
        finish(pA0, pA1); SBAR();
        SLOAD(SO, KBASE(j + 2)); SBAR();
        pv(vb0);
        __syncthreads(); SWAIT(); SWRITE(0, SE);
        lsum_upd();
        if (WIN) win_mask(pB0, pB1, qrow - KBASE(j), hi);
        exp16(pB0);
        __syncthreads();
        SBAR(); qkt<DQ>(pA0, pA1, K_lds, qr, minit, r32, hi);
        finish(pB0, pB1); SBAR();
        if (j + 3 < NT) SLOAD(SE, KBASE(j + 3)); SBAR();
        pv(vb0 + SHM_V);
        __syncthreads(); SWAIT(); SWRITE(1, SO);
        lsum_upd();
        if (WIN) win_mask(pA0, pA1, qrow - KBASE(j + 1), hi);
        exp16(pA0);
        __syncthreads();
    }
    SBAR(); qkt<DQ>(pB0, pB1, K_lds + SHM_K, qr, minit, r32, hi);
    finish(pA0, pA1); SBAR();
    pv(vb0); lsum_upd();
    if (WIN) win_mask(pB0, pB1, qrow - KBASE(NT - 1), hi);
    exp16(pB0);
    finish(pB0, pB1); SBAR();
    pv(vb0 + SHM_V); lsum_upd();
    if (WIN) {
        if (hi == 0) li_l[r32] = m_ref; asm volatile("s_waitcnt lgkmcnt(0)" ::: "memory");
#pragma unroll
        for (int r = 0; r < 16; ++r) lsum[r] += __builtin_amdgcn_exp2f(sink_l2 - li_l[crow(r, hi)]);
    }
    float rli[16]; bool fin = true;
#pragma unroll
    for (int r = 0; r < 16; ++r) { fin = fin && (lsum[r] < ATT_GUARD) && (lsum[r] > 0.f); rli[r] = __builtin_amdgcn_rcpf(lsum[r]); }
    if (!__all(fin)) { if (lane == 0) *redo_flag = 1; }
    bf16_t* Ow = Ob + (size_t)(wid * 32) * LDO;
#pragma unroll
    for (int r = 0; r < 16; ++r) { const int orow = crow(r, hi);
#pragma unroll
        for (int d0 = 0; d0 < 2; ++d0) Ow[(size_t)orow * LDO + d0 * 32 + r32] = (bf16_t)(cvtpk(o[d0][r] * rli[r], 0.f) & 0xffffu); }
    __syncthreads();
    const int redo = __builtin_amdgcn_readfirstlane(*redo_flag);
    __syncthreads();
    return redo;
#undef SLOAD
#undef SWRITE
#undef SWAIT
#undef KBASE
}

__device__ __forceinline__ void phase_attn0(const Params& p, char* lds) {
    const bf16_t* proj = (const bf16_t*)(p.ws + WS_PROJ); bf16_t* att = (bf16_t*)(p.ws + WS_ATT0);
    const float* sink = p.in[4];
    for (int it = blockIdx.x; it < 4096; it += gridDim.x) {
        const int win = it >> 11, r = it & 2047, b = r >> 8, hq = (r >> 5) & 7, qb = r & 31, kvh = hq >> 2;
        const size_t tok0 = (size_t)b * SEQ; const int q0 = qb * 256;
        if (!win) {
            if (attn_body<64, false, 1536, 1536>(proj + (tok0 + q0) * 1536 + hq * 64, proj + tok0 * 1536 + 512 + kvh * 64, nullptr, proj + tok0 * 1536 + 640 + kvh * 64,
                                             att + (tok0 + q0) * 1024 + hq * 64, 0, 128, q0, 0.f, lds))
                attn_body_safe<64, false, 1536, 1536>(proj + (tok0 + q0) * 1536 + hq * 64, proj + tok0 * 1536 + 512 + kvh * 64, nullptr, proj + tok0 * 1536 + 640 + kvh * 64,
                                             att + (tok0 + q0) * 1024 + hq * 64, 0, 128, q0, 0.f, lds);
        } else {
            int t0 = q0 / 64 - 2, t1 = q0 / 64 + 6; if (t0 < 0) t0 = 0; if (t1 > 128) t1 = 128;
            if (attn_body<64, true, 1536, 1536>(proj + (tok0 + q0) * 1536 + 768 + hq * 64, proj + tok0 * 1536 + 1280 + kvh * 64, nullptr, proj + tok0 * 1536 + 1408 + kvh * 64,
                                            att + (tok0 + q0) * 1024 + 512 + hq * 64, t0, t1 - t0, q0, sink[hq] * 1.4426950408889634f, lds))
                attn_body_safe<64, true, 1536, 1536>(proj + (tok0 + q0) * 1536 + 768 + hq * 64, proj + tok0 * 1536 + 1280 + kvh * 64, nullptr, proj + tok0 * 1536 + 1408 + kvh * 64,
                                            att + (tok0 + q0) * 1024 + 512 + hq * 64, t0, t1 - t0, q0, sink[hq] * 1.4426950408889634f, lds);
        }
    }
}
__device__ __forceinline__ void phase_attn1(const Params& p, char* lds) {
    const bf16_t* q = (const bf16_t*)(p.ws + WS_Q); const bf16_t* kv = (const bf16_t*)(p.ws + WS_KV); const bf16_t* kr = (const bf16_t*)(p.ws + WS_KR);
    bf16_t* att = (bf16_t*)(p.ws + WS_ATT1);
    for (int it = blockIdx.x; it < 4096; it += gridDim.x) {
        const int b = it >> 9, h = (it >> 5) & 15, qb = it & 31;
        const size_t tok0 = (size_t)b * SEQ; const int q0 = qb * 256;
        if (attn_body<96, false, 1536, 2048>(q + (tok0 + q0) * 1536 + h * 96, kv + tok0 * 2048 + h * 128, kr + tok0 * 32, kv + tok0 * 2048 + h * 128 + 64,
                                         att + (tok0 + q0) * 1024 + h * 64, 0, 128, q0, 0.f, lds))
            attn_body_safe<96, false, 1536, 2048>(q + (tok0 + q0) * 1536 + h * 96, kv + tok0 * 2048 + h * 128, kr + tok0 * 32, kv + tok0 * 2048 + h * 128 + 64,
                                         att + (tok0 + q0) * 1024 + h * 64, 0, 128, q0, 0.f, lds);
    }
}

__device__ __forceinline__ void phase_ln1(const Params& p, int layer, unsigned char* lds) {
    float* wrt = (float*)lds;
    const float* wr = p.in[14] + (size_t)layer * 1024 * 16;
    for (int i = otid(); i < 16384; i += 512) { const int c = i >> 4, e = i & 15; wrt[e * 1024 + c] = wr[i]; }
    __syncthreads();
    const int tid_ = otid(); const int wid = __builtin_amdgcn_readfirstlane(tid_ >> 6), lane = tid_ & 63;
    const float* g = p.in[12] + layer * 1024; const float* bb = p.in[13] + layer * 1024;
    f32x4 gv[4], bv[4];
#pragma unroll
    for (int j = 0; j < 4; ++j) { gv[j] = *(const f32x4*)(g + j * 256 + lane * 4); bv[j] = *(const f32x4*)(bb + j * 256 + lane * 4); }
    bf16_t* xb = (bf16_t*)(p.ws + WS_XB); float* aff = (float*)(p.ws + WS_AFF); f32x2* stats = (f32x2*)(p.ws + WS_STATS);
    const float* outp = p.out;
    auto process = [&](f32x4 (&v)[4], int t) {
        float s = 0.f;
#pragma unroll
        for (int j = 0; j < 4; ++j) s += v[j][0] + v[j][1] + v[j][2] + v[j][3];
        const float mu = wave_sum(s) * (1.f / 1024.f);
        float q = 0.f;
#pragma unroll
        for (int j = 0; j < 4; ++j)
#pragma unroll
            for (int i = 0; i < 4; ++i) { const float d = v[j][i] - mu; q += d * d; }
        const float rstd = rsqrtf(wave_sum(q) * (1.f / 1024.f) + 1e-5f);
        if (lane == 0) stats[t] = (f32x2){mu, rstd};
#pragma unroll
        for (int j = 0; j < 4; ++j) {
#pragma unroll
            for (int i = 0; i < 4; ++i) v[j][i] = (v[j][i] - mu) * rstd * gv[j][i] + bv[j][i];
            u32x2 w = {cvtpk(v[j][0], v[j][1]), cvtpk(v[j][2], v[j][3])};
            *(u32x2*)(xb + (size_t)t * 1024 + j * 256 + lane * 4) = w;
        }
        float lg[16];
#pragma unroll
        for (int e = 0; e < 16; ++e) {
            float a = 0.f;
#pragma unroll
            for (int j = 0; j < 4; ++j) { const f32x4 w = *(const f32x4*)(wrt + e * 1024 + j * 256 + lane * 4);
                a += v[j][0] * w[0] + v[j][1] * w[1] + v[j][2] * w[2] + v[j][3] * w[3]; }
            lg[e] = wave_sum(a);
        }
        float mx = lg[0];
#pragma unroll
        for (int e = 1; e < 16; ++e) mx = fmaxf(mx, lg[e]);
        float den = 0.f;
#pragma unroll
        for (int e = 0; e < 16; ++e) { lg[e] = __expf(lg[e] - mx); den += lg[e]; }
        const float rden = 1.f / den;
        float mine = 0.f;
#pragma unroll
        for (int e = 0; e < 16; ++e) mine = (lane == e) ? lg[e] * rden : mine;
        const int b = t >> 13, sidx = t & (SEQ - 1);
        if (lane < 16) aff[((size_t)(b * 16 + lane)) * SEQ + sidx] = mine;
    };
    auto loadrow = [&](f32x4 (&d)[4], int t) {
        const float* r = outp + (size_t)t * 1024 + lane * 4;
#pragma unroll
        for (int j = 0; j < 4; ++j) d[j] = *(const f32x4*)(r + j * 256);
    };
    const int st = gridDim.x * 8, t0 = blockIdx.x * 8 + wid;
    f32x4 A_[4], B_[4], v[4];
    loadrow(A_, t0); if (t0 + st < T_TOK) loadrow(B_, t0 + st);
    for (int t = t0; t < T_TOK; t += 2 * st) {
#pragma unroll
        for (int j = 0; j < 4; ++j) v[j] = A_[j];
        if (t + 2 * st < T_TOK) loadrow(A_, t + 2 * st);
        process(v, t);
        if (t + st < T_TOK) {
#pragma unroll
            for (int j = 0; j < 4; ++j) v[j] = B_[j];
            if (t + 3 * st < T_TOK) loadrow(B_, t + 3 * st);
            process(v, t + st);
        }
    }
    __syncthreads();
}

__device__ __forceinline__ void phase_topk(const Params& p, unsigned char* lds) {
    unsigned* red = (unsigned*)lds;
    const int tid = otid(), wid = __builtin_amdgcn_readfirstlane(tid >> 6), lane = tid & 63;
    const float* aff = (const float*)(p.ws + WS_AFF);
    int* idx = (int*)(p.ws + WS_IDX); float* gate = (float*)(p.ws + WS_GATE); int* slot = (int*)(p.ws + WS_SLOT);
    for (int be = blockIdx.x; be < 128; be += gridDim.x) {
        const int b = be >> 4, e = be & 15;
        const float* a = aff + (size_t)be * SEQ + tid * 16;
        unsigned v[16];
#pragma unroll
        for (int j = 0; j < 4; ++j) { const f32x4 x = *(const f32x4*)(a + j * 4);
#pragma unroll
            for (int i = 0; i < 4; ++i) v[j * 4 + i] = __float_as_uint(x[i]); }
        unsigned T = 0;
        for (int bit = 30; bit >= 0; --bit) {
            const unsigned cand = T | (1u << bit);
            unsigned cnt = 0;
#pragma unroll
            for (int j = 0; j < 16; ++j) cnt += (unsigned)__builtin_popcountll(__ballot(v[j] >= cand));
            unsigned* rb = red + (bit & 1) * 8;
            if (lane == 0) rb[wid] = cnt;
            __syncthreads();
            unsigned tot = 0;
#pragma unroll
            for (int w = 0; w < 8; ++w) tot += rb[w];
            if (tot >= 1024u) T = cand;
        }
        __syncthreads();
        unsigned cg_ = 0, ce_ = 0;
#pragma unroll
        for (int j = 0; j < 16; ++j) { cg_ += (v[j] > T) ? 1u : 0u; ce_ += (v[j] == T) ? 1u : 0u; }
        unsigned pk = cg_ | (ce_ << 16), incl = pk;
#pragma unroll
        for (int o = 1; o < 64; o <<= 1) { const unsigned y = __shfl_up(incl, o); if (lane >= o) incl += y; }
        unsigned* sb = red + 32;
        if (lane == 63) sb[wid] = incl;
        __syncthreads();
        unsigned wbase = 0, total = 0;
#pragma unroll
        for (int w = 0; w < 8; ++w) { const unsigned x = sb[w]; if (w < wid) wbase += x; total += x; }
        unsigned excl = wbase + incl - pk;
        unsigned ngt = excl & 0xffffu, neq = excl >> 16;
        const unsigned need_eq = 1024u - (total & 0xffffu);
#pragma unroll
        for (int j = 0; j < 16; ++j) {
            const int tkn = tid * 16 + j;
            const bool isg = v[j] > T, ise = v[j] == T;
            const bool sel = isg || (ise && neq < need_eq);
            const unsigned sl = ngt + (neq < need_eq ? neq : need_eq);
            if (sel) { idx[be * 1024 + sl] = tkn; gate[be * 1024 + sl] = __uint_as_float(v[j]); }
            slot[((size_t)(b * SEQ + tkn)) * 16 + e] = sel ? (int)sl : -1;
            ngt += isg ? 1u : 0u; neq += ise ? 1u : 0u;
        }
        __syncthreads();
    }
}

__device__ __forceinline__ void phase_gather(const Params& p) {
    const int tid_ = otid(); const int wid = __builtin_amdgcn_readfirstlane(tid_ >> 6), lane = tid_ & 63;
    const int* idx = (const int*)(p.ws + WS_IDX); const bf16_t* xb = (const bf16_t*)(p.ws + WS_XB); bf16_t* xg = (bf16_t*)(p.ws + WS_XG);
    for (int r = blockIdx.x * 8 + wid; r < 131072; r += gridDim.x * 8) {
        const int b = r >> 14; const int tk = idx[r];
        const u32x4* src = (const u32x4*)(xb + ((size_t)b * SEQ + tk) * 1024); u32x4* dst = (u32x4*)(xg + (size_t)r * 1024);
        const u32x4 a0 = src[lane], a1 = src[64 + lane];
        dst[lane] = a0; dst[64 + lane] = a1;
    }
}

__device__ __forceinline__ void phase_ln2(const Params& p, int layer, bool write_xb) {
    const int tid_ = otid(); const int wid = __builtin_amdgcn_readfirstlane(tid_ >> 6), lane = tid_ & 63;
    const float* g = p.in[18] + layer * 1024; const float* bb = p.in[19] + layer * 1024;
    const float* g1 = p.in[12] + layer * 1024; const float* b1 = p.in[13] + layer * 1024;
    f32x4 gv[4], bv[4], g1v[4], b1v[4];
#pragma unroll
    for (int j = 0; j < 4; ++j) { gv[j] = *(const f32x4*)(g + j * 256 + lane * 4); bv[j] = *(const f32x4*)(bb + j * 256 + lane * 4);
        g1v[j] = *(const f32x4*)(g1 + j * 256 + lane * 4); b1v[j] = *(const f32x4*)(b1 + j * 256 + lane * 4); }
    bf16_t* xb = (bf16_t*)(p.ws + WS_XB); const int* slot = (const int*)(p.ws + WS_SLOT); const bf16_t* y = (const bf16_t*)(p.ws + WS_Y);
    const f32x2* stats = (const f32x2*)(p.ws + WS_STATS);
    float* outp = p.out;
    auto process = [&](f32x4 (&v)[4], int myslot, f32x2 stt, int t) {
        float* row = outp + (size_t)t * 1024;
        const int b = t >> 13;
#pragma unroll
        for (int j = 0; j < 4; ++j)
#pragma unroll
            for (int i = 0; i < 4; ++i) v[j][i] = ((v[j][i] - stt[0]) * stt[1] * g1v[j][i] + b1v[j][i]) * ALPHA;
        unsigned long long em = __ballot(myslot >= 0 && lane < 16);
        while (em) {
            const int e0 = __builtin_ctzll(em); em &= em - 1;
            const bool two = em != 0ull;
            const int e1 = two ? __builtin_ctzll(em) : e0; if (two) em &= em - 1;
            const int s0 = __builtin_amdgcn_readlane(myslot, e0), s1 = __builtin_amdgcn_readlane(myslot, e1);
            const bf16_t* y0 = y + ((size_t)((b * 16 + e0) * 1024 + s0)) * 1024 + lane * 4;
            const bf16_t* y1 = y + ((size_t)((b * 16 + e1) * 1024 + s1)) * 1024 + lane * 4;
            u32x2 w0[4], w1[4];
#pragma unroll
            for (int j = 0; j < 4; ++j) { w0[j] = *(const u32x2*)(y0 + j * 256); w1[j] = *(const u32x2*)(y1 + j * 256); }
            const float f1 = two ? 1.f : 0.f;
#pragma unroll
            for (int j = 0; j < 4; ++j) {
                v[j][0] += __uint_as_float(w0[j][0] << 16); v[j][1] += __uint_as_float(w0[j][0] & 0xffff0000u);
                v[j][2] += __uint_as_float(w0[j][1] << 16); v[j][3] += __uint_as_float(w0[j][1] & 0xffff0000u);
                v[j][0] += f1 * __uint_as_float(w1[j][0] << 16); v[j][1] += f1 * __uint_as_float(w1[j][0] & 0xffff0000u);
                v[j][2] += f1 * __uint_as_float(w1[j][1] << 16); v[j][3] += f1 * __uint_as_float(w1[j][1] & 0xffff0000u);
            }
        }
        float s = 0.f;
#pragma unroll
        for (int j = 0; j < 4; ++j) s += v[j][0] + v[j][1] + v[j][2] + v[j][3];
        const float mu = wave_sum(s) * (1.f / 1024.f);
        float q = 0.f;
#pragma unroll
        for (int j = 0; j < 4; ++j)
#pragma unroll
            for (int i = 0; i < 4; ++i) { const float d = v[j][i] - mu; q += d * d; }
        const float rstd = rsqrtf(wave_sum(q) * (1.f / 1024.f) + 1e-5f);
#pragma unroll
        for (int j = 0; j < 4; ++j) {
#pragma unroll
            for (int i = 0; i < 4; ++i) v[j][i] = (v[j][i] - mu) * rstd * gv[j][i] + bv[j][i];
            *(f32x4*)(row + j * 256 + lane * 4) = v[j];
            if (write_xb) { u32x2 w = {cvtpk(v[j][0], v[j][1]), cvtpk(v[j][2], v[j][3])}; *(u32x2*)(xb + (size_t)t * 1024 + j * 256 + lane * 4) = w; }
        }
    };
    auto loadrow = [&](f32x4 (&d)[4], int& sl, f32x2& stt, int t) {
        const float* r = outp + (size_t)t * 1024 + lane * 4;
#pragma unroll
        for (int j = 0; j < 4; ++j) d[j] = *(const f32x4*)(r + j * 256);
        sl = slot[(size_t)t * 16 + (lane & 15)]; stt = stats[t];
    };
    const int st = gridDim.x * 8, t0 = blockIdx.x * 8 + wid;
    f32x4 A_[4], B_[4], v[4]; int sA = -1, sB = -1; f32x2 tA = {0.f, 0.f}, tB = {0.f, 0.f};
    loadrow(A_, sA, tA, t0); if (t0 + st < T_TOK) loadrow(B_, sB, tB, t0 + st);
    for (int t = t0; t < T_TOK; t += 2 * st) {
        { const int sl = sA; const f32x2 stt = tA;
#pragma unroll
          for (int j = 0; j < 4; ++j) v[j] = A_[j];
          if (t + 2 * st < T_TOK) loadrow(A_, sA, tA, t + 2 * st);
          process(v, sl, stt, t); }
        if (t + st < T_TOK) {
            const int sl = sB; const f32x2 stt = tB;
#pragma unroll
            for (int j = 0; j < 4; ++j) v[j] = B_[j];
            if (t + 3 * st < T_TOK) loadrow(B_, sB, tB, t + 3 * st);
            process(v, sl, stt, t + st);
        }
    }
}

__device__ __forceinline__ void phase_mlaprep(const Params& p) {
    const int tid_ = otid(); const int wid = __builtin_amdgcn_readfirstlane(tid_ >> 6), lane = tid_ & 63;
    const float* raw = (const float*)(p.ws + WS_RAWDN);
    bf16_t* cqn = (bf16_t*)(p.ws + WS_CQN); bf16_t* ckvn = (bf16_t*)(p.ws + WS_CKVN); bf16_t* kr = (bf16_t*)(p.ws + WS_KR);
    const float* mc = (const float*)(p.ws + TAB_MLA_C); const float* ms = (const float*)(p.ws + TAB_MLA_S);
    const f32x4 qn = *(const f32x4*)(p.in[7] + lane * 4); const f32x2 kn = *(const f32x2*)(p.in[8] + lane * 2);
    for (int t = blockIdx.x * 8 + wid; t < T_TOK; t += gridDim.x * 8) {
        const float* r = raw + (size_t)t * 512;
        const f32x4 cq = *(const f32x4*)(r + lane * 4); const f32x2 ck = *(const f32x2*)(r + 256 + lane * 2);
        const float rq = rsqrtf(wave_sum(cq[0] * cq[0] + cq[1] * cq[1] + cq[2] * cq[2] + cq[3] * cq[3]) * (1.f / 256.f) + 1e-6f);
        const float rk = rsqrtf(wave_sum(ck[0] * ck[0] + ck[1] * ck[1]) * (1.f / 128.f) + 1e-6f);
        u32x2 wq = {cvtpk(cq[0] * rq * qn[0], cq[1] * rq * qn[1]), cvtpk(cq[2] * rq * qn[2], cq[3] * rq * qn[3])};
        *(u32x2*)(cqn + (size_t)t * 256 + lane * 4) = wq;
        *(unsigned*)(ckvn + (size_t)t * 128 + lane * 2) = cvtpk(ck[0] * rk * kn[0], ck[1] * rk * kn[1]);
        if (lane < 16) { const int s = t & (SEQ - 1); const float x1 = r[384 + lane], x2 = r[400 + lane]; const float c = mc[s * 16 + lane], sn = ms[s * 16 + lane];
            *(unsigned*)(kr + (size_t)t * 32 + 2 * lane) = cvtpk(x1 * c - x2 * sn, x2 * c + x1 * sn); }
    }
}

#define XB_TMO      128
#define XB_XCNT(j)  (256  + 64 * (j))
#define XB_XSUB(j)  (1280 + 64 * (j))
#define XB_XGEN(j)  (2304 + 64 * (j))
#define XB_TOP      3328
#define XB_TOPGEN   3392
#define XCD_BAR_WORDS 3456
#define XB_SPIN_CAP (1u << 20)
__device__ __forceinline__ unsigned xb_ld(unsigned* p)              { return __hip_atomic_load(p, __ATOMIC_RELAXED, __HIP_MEMORY_SCOPE_AGENT); }
__device__ __forceinline__ unsigned xb_add(unsigned* p, unsigned v) { return __hip_atomic_fetch_add(p, v, __ATOMIC_RELAXED, __HIP_MEMORY_SCOPE_AGENT); }
__device__ __forceinline__ unsigned xb_xcc_id() { return (unsigned)__builtin_amdgcn_s_getreg((3 << 11) | 20) & 0xFu; }
#define XB_SPIN(cond, bar) do { unsigned _sp = 0; while (cond) { __builtin_amdgcn_s_sleep(1); \
    if ((++_sp & 255u) == 0u) { if (xb_ld(&(bar)[XB_TMO])) break; if (_sp > XB_SPIN_CAP) { atomicAdd(&(bar)[XB_TMO], 1u); break; } } } } while (0)
struct XcdBarrier { unsigned* bar; unsigned x; volatile LAS unsigned* st; };
__device__ __forceinline__ XcdBarrier xcd_barrier_post(unsigned* bar, volatile LAS unsigned* st) {
    XcdBarrier b; b.bar = bar; b.x = xb_xcc_id(); b.st = st;
    if (threadIdx.x == 0) (void)xb_add(&bar[XB_XCNT(b.x)], 1u);
    return b;
}
__device__ __forceinline__ void xcd_barrier_complete(unsigned* bar, unsigned x, unsigned& nloc, unsigned& nx) {
    const unsigned G = gridDim.x * gridDim.y * gridDim.z;
    unsigned sum, cnt, mine, sp = 0u;
    for (;;) {
        sum = 0u; cnt = 0u; mine = 0u;
#pragma unroll
        for (unsigned j = 0; j < 16; ++j) { const unsigned c = xb_ld(&bar[XB_XCNT(j)]); sum += c; cnt += (c > 0u) ? 1u : 0u; mine = (j == x) ? c : mine; }
        if (sum == G) break;
        __builtin_amdgcn_s_sleep(1);
        if ((++sp & 255u) == 0u) { if (xb_ld(&bar[XB_TMO])) break; if (sp > XB_SPIN_CAP) { atomicAdd(&bar[XB_TMO], 1u); break; } }
    }
    nloc = mine > 0u ? mine : 1u; nx = cnt > 0u ? cnt : 1u;
}
__device__ __forceinline__ void xcd_barrier(const XcdBarrier& b) {
    asm volatile("s_waitcnt vmcnt(0)" ::: "memory");
    __syncthreads();
    if (threadIdx.x == 0) {
        unsigned* bar = b.bar;
        __builtin_amdgcn_s_waitcnt(0);
        unsigned nloc = b.st[0], nx = b.st[1];
        if (nloc == 0u) { xcd_barrier_complete(bar, b.x, nloc, nx); b.st[0] = nloc; b.st[1] = nx; }
        const unsigned old = xb_add(&bar[XB_XSUB(b.x)], 1u);
        const unsigned gen = old / nloc;
        if (old + 1u == (gen + 1u) * nloc) {
            __builtin_amdgcn_fence(__ATOMIC_RELEASE, "agent");
            asm volatile("s_waitcnt vmcnt(0)" ::: "memory");
            const unsigned og = xb_add(&bar[XB_TOP], 1u);
            const unsigned tg = og / nx;
            if (og + 1u == (tg + 1u) * nx) xb_add(&bar[XB_TOPGEN], 1u);
            else XB_SPIN(xb_ld(&bar[XB_TOPGEN]) == tg, bar);
            __builtin_amdgcn_fence(__ATOMIC_ACQUIRE, "agent");
            xb_add(&bar[XB_XGEN(b.x)], 1u);
            asm volatile("s_waitcnt vmcnt(0)" ::: "memory");
        } else {
            XB_SPIN(xb_ld(&bar[XB_XGEN(b.x)]) == gen, bar);
            __builtin_amdgcn_fence(__ATOMIC_ACQUIRE, "agent");
            asm volatile("s_waitcnt vmcnt(0)" ::: "memory");
        }
    }
    __syncthreads();
}

__global__ void __launch_bounds__(512, 2) mega(Params p) {
    extern __shared__ __attribute__((aligned(16))) unsigned char shm[];
    cg::grid_group grid = cg::this_grid();
    LAS unsigned char* lds3 = (LAS unsigned char*)shm;
    unsigned char* ws = p.ws;
    const int G = gridDim.x, c = blockIdx.x;
    int ph = 0;
    volatile LAS unsigned* xst = (volatile LAS unsigned*)(lds3 + 131072);
    if (threadIdx.x == 0) { xst[0] = 0u; xst[1] = 0u; }
    __syncthreads();
    XcdBarrier xbar = xcd_barrier_post((unsigned*)(ws + WS_BAR), xst);
#ifndef SITE_MASK
#define SITE_MASK 0xffff
#endif
#ifndef DUP_MASK
#define DUP_MASK 0
#endif
#define PHASE_BEGIN(site) if (((SITE_MASK >> (site)) & 1) && ph >= p.ph_lo && ph < p.ph_hi) for (int rep_ = 0; rep_ < 1 + ((DUP_MASK >> (site)) & 1); ++rep_) {
#define PHASE_END } ++ph; if (ph > p.ph_lo && ph < p.ph_hi) { if (p.ph_lo < 0) grid.sync(); xcd_barrier(xbar); }
    PHASE_BEGIN(0) phase_convert(p, shm); PHASE_END
#ifdef EXTRA_SYNCS
    for (int i_ = 0; i_ < EXTRA_SYNCS; ++i_) xcd_barrier(xbar);
#endif
    const float* tsc = (const float*)(ws + TAB_SEQ_C); const float* tss = (const float*)(ws + TAB_SEQ_S);
    const float* tmc = (const float*)(ws + TAB_MLA_C); const float* tms = (const float*)(ws + TAB_MLA_S);
    const float* trc = (const float*)(ws + TAB_ROW_C); const float* trs = (const float*)(ws + TAB_ROW_S);
    const float* tcc = (const float*)(ws + TAB_COL_C); const float* tcs = (const float*)(ws + TAB_COL_S);
    const bf16_t* xb = (const bf16_t*)(ws + WS_XB);
    PHASE_BEGIN(1) { Sched S{256, 6, 1536, G, c, 0}; EpiQKV0 E{(bf16_t*)(ws + WS_PROJ), p.in[2], p.in[3], trc, trs, tcc, tcs, tsc, tss};
        gemm_phase(lds3, xb, (const bf16_t*)(ws + W_IN0), 1024, S, E); } PHASE_END
    PHASE_BEGIN(2) phase_attn0(p, (char*)shm); PHASE_END
    PHASE_BEGIN(3) { Sched S{256, 4, 1024, G, c, 0}; EpiRes E{p.in[0], p.out};
        gemm_phase(lds3, (const bf16_t*)(ws + WS_ATT0), (const bf16_t*)(ws + W_OUT0), 1024, S, E); } PHASE_END
    for (int layer = 0; layer < 2; ++layer) {
        if (layer == 1) {
            PHASE_BEGIN(4) { Sched S{256, 2, 512, G, c, 0}; EpiF32 E{(float*)(ws + WS_RAWDN), 512};
                gemm_phase(lds3, xb, (const bf16_t*)(ws + W_DN1), 1024, S, E); } PHASE_END
            PHASE_BEGIN(5) phase_mlaprep(p); PHASE_END
            PHASE_BEGIN(6) { Sched S{256, 6, 1536, G, c, 0}; EpiBf16<2> E{(bf16_t*)(ws + WS_Q), 1536, nullptr, tmc, tms};
                    gemm_phase(lds3, (const bf16_t*)(ws + WS_CQN), (const bf16_t*)(ws + W_UQ), 256, S, E); } PHASE_END
            PHASE_BEGIN(15) { Sched S{256, 8, 2048, G, c, 0}; EpiBf16<0> E{(bf16_t*)(ws + WS_KV), 2048, nullptr, nullptr, nullptr};
                    gemm_phase(lds3, (const bf16_t*)(ws + WS_CKVN), (const bf16_t*)(ws + W_UKV), 128, S, E); } PHASE_END
            PHASE_BEGIN(7) phase_attn1(p, (char*)shm); PHASE_END
            PHASE_BEGIN(8) { Sched S{256, 4, 1024, G, c, 0}; EpiRes E{p.out, p.out};
                gemm_phase(lds3, (const bf16_t*)(ws + WS_ATT1), (const bf16_t*)(ws + W_OUT1), 1024, S, E); } PHASE_END
        }
        PHASE_BEGIN(9) phase_ln1(p, layer, shm); PHASE_END
        PHASE_BEGIN(10) phase_topk(p, shm); PHASE_END
        PHASE_BEGIN(12) { Sched S{4, 8, 4096, G, c, 1}; EpiSwiGLU E{(bf16_t*)(ws + WS_H)};
            gemm_phase<EpiSwiGLU, true>(lds3, xb, (const bf16_t*)(ws + (layer ? W_GU1 : W_GU0)), 1024, S, E, (const int*)(ws + WS_IDX)); } PHASE_END
        PHASE_BEGIN(13) { Sched S{4, 4, 2048, G, c, 1}; EpiBf16<1> E{(bf16_t*)(ws + WS_Y), 1024, (const float*)(ws + WS_GATE), nullptr, nullptr};
            gemm_phase(lds3, (const bf16_t*)(ws + WS_H), (const bf16_t*)(ws + (layer ? W_D1 : W_D0)), 1024, S, E); } PHASE_END
        PHASE_BEGIN(14) phase_ln2(p, layer, layer == 0); PHASE_END
    }
}

extern "C" void kernel_launch(void* const* d_in, const int* in_sizes, int n_in, void* d_out, int out_size, void* d_ws, size_t ws_size, hipStream_t stream) {
    static int grid = 0;
    if (grid == 0) {
        if (n_in != 20 || out_size != T_TOK * DM || ws_size < WS_END) { fprintf(stderr, "kernel_launch: unexpected shapes n_in %d out %d ws %zu (need %zu)\n", n_in, out_size, ws_size, (size_t)WS_END); grid = -1; return; }
        int dev = 0, cus = 0, per_cu = 0;
        hipGetDevice(&dev); hipDeviceGetAttribute(&cus, hipDeviceAttributeMultiprocessorCount, dev);
        if (hipFuncSetAttribute((const void*)mega, hipFuncAttributeMaxDynamicSharedMemorySize, LDS_BYTES) != hipSuccess) { fprintf(stderr, "kernel_launch: hipFuncSetAttribute failed\n"); grid = -1; return; }
        if (hipOccupancyMaxActiveBlocksPerMultiprocessor(&per_cu, (const void*)mega, 512, LDS_BYTES) != hipSuccess || per_cu < 1) { fprintf(stderr, "kernel_launch: occupancy query %d\n", per_cu); per_cu = 1; }
        (void)hipGetLastError();
        grid = cus * 1;
    }
    if (grid < 0) return;
    Params p{};
    for (int i = 0; i < 20; ++i) p.in[i] = (const float*)d_in[i];
    p.out = (float*)d_out; p.ws = (unsigned char*)d_ws; p.ph_lo = 0; p.ph_hi = 1000;
    if (hipMemsetAsync((char*)d_ws + WS_BAR, 0, XCD_BAR_WORDS * 4, stream) != hipSuccess) { fprintf(stderr, "kernel_launch: memset failed\n"); return; }
    void* args[] = {&p};
    hipError_t e = hipLaunchCooperativeKernel((const void*)mega, dim3(grid), dim3(512), args, LDS_BYTES, stream);
    if (e != hipSuccess) fprintf(stderr, "kernel_launch: cooperative launch failed: %s (grid %d)\n", hipGetErrorString(e), grid);
}
```
